# Optimizing an MI355X kernel written in HIP

```python
import math
import jax, jax.numpy as jnp
from jax import lax
import numpy as np

D_MODEL = 1024
BATCH = 4
SEQ = 8192
DEPTH = 2

N_BRANCH = 3
BRANCH_DIM = D_MODEL
CONV_DIM = BRANCH_DIM
CONV_WIDTH = 3
MLSTM_HEADS = 8
MLSTM_DV = BRANCH_DIM // MLSTM_HEADS
MLSTM_DK = MLSTM_DV // 2
MLSTM_CHUNK = 128
GATE_CAP = 15.0
MLA_NOPE = 128
MLA_ROPE = 64
MLA_V = 128
MLA_HEADS = BRANCH_DIM // MLA_V
Q_LORA = D_MODEL // 4
KV_LORA = D_MODEL // 8
ROPE_BASE = 10000.0
ATTN_BLOCK = 128
D_FF = 4 * D_MODEL
NORM_EPS = 1e-6

IN_SPLITS = (
    CONV_DIM, CONV_DIM, CONV_DIM,
    MLSTM_HEADS * MLSTM_DK, MLSTM_HEADS * MLSTM_DK,
    MLSTM_HEADS * MLSTM_DV, MLSTM_HEADS * MLSTM_DV,
    MLSTM_HEADS, MLSTM_HEADS,
    Q_LORA, KV_LORA, MLA_ROPE,
    N_BRANCH * D_MODEL,
)
IN_DIM = (3 * CONV_DIM + 2 * MLSTM_HEADS * MLSTM_DK + 2 * MLSTM_HEADS * MLSTM_DV + 2 * MLSTM_HEADS
          + Q_LORA + KV_LORA + MLA_ROPE + N_BRANCH * D_MODEL)

kernel_name = 'hybrid_conv_mlstm_mla_gated_block'


def rms_norm(x, g):
    xf = x.astype(jnp.float32)
    y = xf * lax.rsqrt(jnp.mean(xf * xf, axis=-1, keepdims=True) + NORM_EPS)
    return (y * g.astype(jnp.float32)).astype(x.dtype)


def rope_tables(positions):
    inv_freq = ROPE_BASE ** (-jnp.arange(0, MLA_ROPE, 2, dtype=jnp.float32) / MLA_ROPE)
    ang = positions.astype(jnp.float32)[..., None] * inv_freq
    return jnp.cos(ang), jnp.sin(ang)


def apply_rope(x, cos, sin):
    half = MLA_ROPE // 2
    xf = x.astype(jnp.float32)
    x1, x2 = xf[..., :half], xf[..., half:]
    out = jnp.concatenate([x1 * cos - x2 * sin, x1 * sin + x2 * cos], axis=-1)
    return out.astype(x.dtype)


def split_columns(proj):
    idx = np.cumsum(np.array(IN_SPLITS))[:-1].tolist()
    return jnp.split(proj, idx, axis=-1)


def soft_cap(z):
    return GATE_CAP * jnp.tanh(z / GATE_CAP)


def short_conv_mixer(gate_b, gate_c, u, conv_w):
    z = gate_c * u
    zc = lax.conv_general_dilated(
        z, conv_w[:, None, :].astype(z.dtype), window_strides=(1,),
        padding=[(CONV_WIDTH - 1, 0)],
        dimension_numbers=('NWC', 'WIO', 'NWC'),
        feature_group_count=CONV_DIM)
    return gate_b * zc


def mlstm_mixer(q, k, v, o_pre, i_pre, f_pre, b_i, b_f, head_norm):
    bsz, seq = q.shape[:2]
    nc, L = seq // MLSTM_CHUNK, MLSTM_CHUNK
    f32 = jnp.float32

    def heads(t, d):
        return t.astype(f32).reshape(bsz, nc, L, MLSTM_HEADS, d).transpose(0, 3, 1, 2, 4)

    qh = heads(q, MLSTM_DK) * (MLSTM_DK ** -0.5)
    kh = heads(k, MLSTM_DK)
    vh = heads(v, MLSTM_DV)
    log_i = soft_cap(i_pre.astype(f32) + b_i.astype(f32))
    log_f = jax.nn.log_sigmoid(soft_cap(f_pre.astype(f32) + b_f.astype(f32)))
    log_i = log_i.reshape(bsz, nc, L, MLSTM_HEADS).transpose(0, 3, 1, 2)
    log_f = log_f.reshape(bsz, nc, L, MLSTM_HEADS).transpose(0, 3, 1, 2)

    b = jnp.cumsum(log_f, axis=-1)
    b_last = b[..., -1]
    a = b_last[..., None] - b + log_i
    m_loc = jnp.max(a, axis=-1)
    w = jnp.exp(a - m_loc[..., None])
    c_loc = jnp.einsum('bhcs,bhcsk,bhcsv->bhckv', w, kh, vh)
    n_loc = jnp.einsum('bhcs,bhcsk->bhck', w, kh)

    def step(carry, xs):
        c_st, n_st, m_st = carry
        bl, ml, cl, nl = xs
        m_new = jnp.maximum(bl + m_st, ml)
        s_old = jnp.exp(bl + m_st - m_new)
        s_loc = jnp.exp(ml - m_new)
        c_new = s_old[..., None, None] * c_st + s_loc[..., None, None] * cl
        n_new = s_old[..., None] * n_st + s_loc[..., None] * nl
        return (c_new, n_new, m_new), (c_st, n_st, m_st)

    init = (jnp.zeros((bsz, MLSTM_HEADS, MLSTM_DK, MLSTM_DV), f32),
            jnp.zeros((bsz, MLSTM_HEADS, MLSTM_DK), f32),
            jnp.zeros((bsz, MLSTM_HEADS), f32))
    xs = (jnp.moveaxis(b_last, 2, 0), jnp.moveaxis(m_loc, 2, 0),
          jnp.moveaxis(c_loc, 2, 0), jnp.moveaxis(n_loc, 2, 0))
    _, (c_prev, n_prev, m_prev) = lax.scan(step, init, xs)
    c_prev = jnp.moveaxis(c_prev, 0, 2)
    n_prev = jnp.moveaxis(n_prev, 0, 2)
    m_prev = jnp.moveaxis(m_prev, 0, 2)

    g = b + m_prev[..., None]
    d = b[..., :, None] - b[..., None, :] + log_i[..., None, :]
    causal = jnp.tril(jnp.ones((L, L), dtype=bool))
    d = jnp.where(causal, d, -jnp.inf)
    m_t = jnp.maximum(g, jnp.max(d, axis=-1))
    inter = jnp.exp(g - m_t)
    s = jnp.einsum('bhctk,bhcsk->bhcts', qh, kh) * jnp.exp(d - m_t[..., None])
    num = inter[..., None] * jnp.einsum('bhctk,bhckv->bhctv', qh, c_prev) + jnp.einsum('bhcts,bhcsv->bhctv', s, vh)
    den = inter * jnp.einsum('bhctk,bhck->bhct', qh, n_prev) + jnp.sum(s, axis=-1)
    h = num / jnp.maximum(jnp.abs(den), jnp.exp(-m_t))[..., None]
    h = h.transpose(0, 2, 3, 1, 4).reshape(bsz, seq, MLSTM_HEADS, MLSTM_DV)
    h = rms_norm(h, head_norm.reshape(MLSTM_HEADS, MLSTM_DV))
    h = h.reshape(bsz, seq, MLSTM_HEADS * MLSTM_DV) * jax.nn.sigmoid(o_pre.astype(f32))
    return h.astype(q.dtype)


def blocked_causal_attention(q, k, v):
    bsz, nh, seq, dh = q.shape
    nb = seq // ATTN_BLOCK
    scale = dh ** -0.5
    qb = q.reshape(bsz, nh, nb, ATTN_BLOCK, dh).transpose(2, 0, 1, 3, 4)
    key_idx = jnp.arange(seq)

    def one_block(args):
        qi, bi = args
        sc = jnp.einsum('bhqd,bhkd->bhqk', qi, k).astype(jnp.float32) * scale
        q_idx = bi * ATTN_BLOCK + jnp.arange(ATTN_BLOCK)
        sc = jnp.where(key_idx[None, :] <= q_idx[:, None], sc, -jnp.inf)
        p = jax.nn.softmax(sc, axis=-1)
        return jnp.einsum('bhqk,bhkd->bhqd', p.astype(v.dtype), v)

    out = lax.map(one_block, (qb, jnp.arange(nb)))
    return out.transpose(1, 2, 0, 3, 4).reshape(bsz, nh, seq, v.shape[-1])


def mla_mixer(c_q, c_kv, k_rope, q_a_norm, w_uq, kv_a_norm, w_ukv, q_norm, k_norm, cos, sin):
    bsz, seq = c_q.shape[:2]
    q = (rms_norm(c_q, q_a_norm) @ w_uq).reshape(bsz, seq, MLA_HEADS, MLA_NOPE + MLA_ROPE)
    kv = (rms_norm(c_kv, kv_a_norm) @ w_ukv).reshape(bsz, seq, MLA_HEADS, MLA_NOPE + MLA_V)
    q_nope = rms_norm(q[..., :MLA_NOPE], q_norm[:MLA_NOPE])
    q_pe = apply_rope(rms_norm(q[..., MLA_NOPE:], q_norm[MLA_NOPE:]), cos[:, :, None, :], sin[:, :, None, :])
    k_nope = rms_norm(kv[..., :MLA_NOPE], k_norm[:MLA_NOPE])
    v = kv[..., MLA_NOPE:]
    k_pe = apply_rope(rms_norm(k_rope, k_norm[MLA_NOPE:]), cos, sin)
    k_pe = jnp.broadcast_to(k_pe[:, :, None, :], (bsz, seq, MLA_HEADS, MLA_ROPE))
    qh = jnp.concatenate([q_nope, q_pe], axis=-1).transpose(0, 2, 1, 3)
    kh = jnp.concatenate([k_nope, k_pe], axis=-1).transpose(0, 2, 1, 3)
    vh = v.transpose(0, 2, 1, 3)
    o = blocked_causal_attention(qh, kh, vh)
    return o.transpose(0, 2, 1, 3).reshape(bsz, seq, MLA_HEADS * MLA_V)


def hybrid_layer(x, cos, sin, mix_norm, w_in, conv_w, b_i, b_f, head_norm,
                 q_a_norm, w_uq, kv_a_norm, w_ukv, q_norm, k_norm,
                 w_branch, w_out, mlp_norm, w_up, w_down):
    bsz, seq = x.shape[:2]
    xn = rms_norm(x, mix_norm)
    (cb, cc, cu, mq, mk, mv, mo, mi, mf, cq, ckv, krope, gate_pre) = split_columns(xn @ w_in)
    y_a = short_conv_mixer(cb, cc, cu, conv_w)
    y_b = mlstm_mixer(mq, mk, mv, mo, mi, mf, b_i, b_f, head_norm)
    y_c = mla_mixer(cq, ckv, krope, q_a_norm, w_uq, kv_a_norm, w_ukv, q_norm, k_norm, cos, sin)
    ys = jnp.stack([y_a, y_b, y_c], axis=0)
    branch = jnp.einsum('nbsc,ncd->nbsd', ys, w_branch)
    gates = jax.nn.sigmoid(gate_pre.reshape(bsz, seq, N_BRANCH, D_MODEL))
    merged = jnp.einsum('bsnd,nbsd->bsd', gates, branch)
    x = x + merged @ w_out
    h = rms_norm(x, mlp_norm)
    x = x + jnp.square(jax.nn.relu(h @ w_up)) @ w_down
    return x


def setup_inputs(seed: int = 0) -> dict:
    key = jax.random.key(seed)
    ks = jax.random.split(key, 24)
    f32 = jnp.float32

    def nrm(k, shape, scale):
        return jax.random.normal(k, shape, f32) * scale

    def gain(k, shape):
        return 1.0 + 0.1 * jax.random.normal(k, shape, f32)

    x = jax.random.normal(ks[0], (BATCH, SEQ, D_MODEL), f32)
    offsets = jax.random.randint(ks[1], (BATCH, 1), 0, 4096, dtype=jnp.int32)
    positions = (offsets + jnp.arange(SEQ, dtype=jnp.int32)[None, :]).astype(jnp.int32)
    f_bias = jnp.linspace(3.0, 6.0, MLSTM_HEADS, dtype=f32)[None, :] + 0.1 * jax.random.normal(ks[5], (DEPTH, MLSTM_HEADS), f32)
    return {
        'x': x,
        'positions': positions,
        'mix_norm': gain(ks[2], (DEPTH, D_MODEL)),
        'w_in': nrm(ks[3], (DEPTH, D_MODEL, IN_DIM), D_MODEL ** -0.5),
        'conv_w': nrm(ks[4], (DEPTH, CONV_WIDTH, CONV_DIM), CONV_WIDTH ** -0.5),
        'mlstm_igate_bias': nrm(ks[6], (DEPTH, MLSTM_HEADS), 0.1),
        'mlstm_fgate_bias': f_bias,
        'mlstm_head_norm': gain(ks[7], (DEPTH, MLSTM_HEADS * MLSTM_DV)),
        'mla_q_a_norm': gain(ks[8], (DEPTH, Q_LORA)),
        'mla_w_uq': nrm(ks[9], (DEPTH, Q_LORA, MLA_HEADS * (MLA_NOPE + MLA_ROPE)), Q_LORA ** -0.5),
        'mla_kv_a_norm': gain(ks[10], (DEPTH, KV_LORA)),
        'mla_w_ukv': nrm(ks[11], (DEPTH, KV_LORA, MLA_HEADS * (MLA_NOPE + MLA_V)), KV_LORA ** -0.5),
        'mla_q_norm': gain(ks[12], (DEPTH, MLA_NOPE + MLA_ROPE)),
        'mla_k_norm': gain(ks[13], (DEPTH, MLA_NOPE + MLA_ROPE)),
        'w_branch': nrm(ks[14], (DEPTH, N_BRANCH, BRANCH_DIM, D_MODEL), BRANCH_DIM ** -0.5),
        'w_out': nrm(ks[15], (DEPTH, D_MODEL, D_MODEL), D_MODEL ** -0.5),
        'mlp_norm': gain(ks[16], (DEPTH, D_MODEL)),
        'w_up': nrm(ks[17], (DEPTH, D_MODEL, D_FF), D_MODEL ** -0.5),
        'w_down': nrm(ks[18], (DEPTH, D_FF, D_MODEL), D_FF ** -0.5),
    }


def reference(x, positions, mix_norm, w_in, conv_w, mlstm_igate_bias, mlstm_fgate_bias,
              mlstm_head_norm, mla_q_a_norm, mla_w_uq, mla_kv_a_norm, mla_w_ukv,
              mla_q_norm, mla_k_norm, w_branch, w_out, mlp_norm, w_up, w_down):
    cos, sin = rope_tables(positions)
    for l in range(DEPTH):
        x = hybrid_layer(x, cos, sin, mix_norm[l], w_in[l], conv_w[l],
                         mlstm_igate_bias[l], mlstm_fgate_bias[l], mlstm_head_norm[l],
                         mla_q_a_norm[l], mla_w_uq[l], mla_kv_a_norm[l], mla_w_ukv[l],
                         mla_q_norm[l], mla_k_norm[l], w_branch[l], w_out[l],
                         mlp_norm[l], w_up[l], w_down[l])
    return x
```

```cpp
#include <hip/hip_runtime.h>
#include <hip/hip_cooperative_groups.h>
#include <cstdio>
#include <cstdint>
namespace cg = cooperative_groups;

typedef unsigned short bf16_t;
typedef short bf16x8 __attribute__((ext_vector_type(8)));
typedef float f32x4 __attribute__((ext_vector_type(4)));

constexpr int TR = 8192;
constexpr int NBATCH = 4, NLAYER = 2;
constexpr int NIN = 9728;
constexpr int NIN_O = 9680;
constexpr float EPS = 1e-6f;
constexpr size_t LDS_BYTES = 73728;
constexpr size_t LDS_TOTAL = 2 * LDS_BYTES + 256;

constexpr size_t al256(size_t x) { return (x + 255) & ~(size_t)255; }
constexpr size_t SZ_WIN = (size_t)NIN * 1024 * 2, SZ_WUQ = 1536 * 256 * 2, SZ_WUKV = 2048 * 128 * 2, SZ_WBR = (size_t)3 * 1024 * 1024 * 2,
                 SZ_WOUT = 1024 * 1024 * 2, SZ_WUP = (size_t)4096 * 1024 * 2, SZ_WDN = (size_t)4096 * 1024 * 2;
constexpr size_t OFF_WIN = 0;
constexpr size_t OFF_WUQ = OFF_WIN + 2 * SZ_WIN;
constexpr size_t OFF_WUKV = OFF_WUQ + 2 * SZ_WUQ;
constexpr size_t OFF_WBR = OFF_WUKV + 2 * SZ_WUKV;
constexpr size_t OFF_WOUT = OFF_WBR + 2 * SZ_WBR;
constexpr size_t OFF_WUP = OFF_WOUT + 2 * SZ_WOUT;
constexpr size_t OFF_WDN = OFF_WUP + 2 * SZ_WUP;
constexpr size_t OFF_XB = OFF_WDN + 2 * SZ_WDN;
constexpr size_t OFF_SSX = OFF_XB + (size_t)32768 * 1024 * 2;
constexpr size_t OFF_COS = OFF_SSX + (size_t)32768 * 16 * 4;
constexpr size_t OFF_SIN = OFF_COS + (size_t)32768 * 32 * 4;
constexpr size_t OFF_CONV = OFF_SIN + (size_t)32768 * 32 * 4;
constexpr size_t OFF_GATES = OFF_CONV + (size_t)TR * 3072 * 2;
constexpr size_t OFF_H = OFF_CONV;
constexpr size_t OFF_MQ = OFF_GATES + (size_t)TR * 3072 * 2;
constexpr size_t OFF_MK = OFF_MQ + (size_t)TR * 512 * 2;
constexpr size_t OFF_MVT = OFF_MK + (size_t)TR * 512 * 2;
constexpr size_t OFF_MO = OFF_MVT + (size_t)TR * 1024 * 2;
constexpr size_t OFF_MIF = OFF_MO + (size_t)TR * 1024 * 2;
constexpr size_t OFF_CQ = OFF_MIF + (size_t)TR * 16 * 4;
constexpr size_t OFF_CKV = OFF_CQ + (size_t)TR * 256 * 2;
constexpr size_t OFF_SSCQ = OFF_CKV + (size_t)TR * 128 * 2;
constexpr size_t OFF_SSCKV = OFF_SSCQ + (size_t)TR * 4 * 4;
constexpr size_t OFF_K = OFF_SSCKV + (size_t)TR * 2 * 4;
constexpr size_t OFF_Q = OFF_K + (size_t)TR * 1536 * 2;
constexpr size_t OFF_VT = OFF_Q + (size_t)TR * 1536 * 2;
constexpr size_t OFF_YA = OFF_VT + (size_t)TR * 1024 * 2;
constexpr size_t OFF_XB1 = OFF_YA;
constexpr size_t OFF_YB = OFF_YA + (size_t)TR * 1024 * 2;
constexpr size_t OFF_YC = OFF_YB + (size_t)TR * 1024 * 2;
constexpr size_t OFF_MRG = OFF_YC + (size_t)TR * 1024 * 2;
constexpr size_t OFF_SS1 = OFF_MRG + (size_t)TR * 1024 * 2;
constexpr size_t OFF_CLOC = OFF_SS1 + (size_t)TR * 16 * 4;
constexpr size_t OFF_NLOC = OFF_CLOC + (size_t)512 * 8192 * 4;
constexpr size_t OFF_BL = OFF_NLOC + (size_t)512 * 64 * 4;
constexpr size_t OFF_CMX = OFF_BL + 512 * 4;
constexpr size_t OFF_CPREV = OFF_CMX + 512 * 4;
constexpr size_t OFF_NPREV = OFF_CPREV + (size_t)512 * 8192 * 2;
constexpr size_t OFF_MPREV = OFF_NPREV + (size_t)512 * 64 * 4;
constexpr size_t OFF_END = OFF_MPREV + 512 * 4;
constexpr size_t OFF_BAR = al256(OFF_END);
static_assert(OFF_BAR + 16384 <= (size_t)512 * 1024 * 1024, "workspace overflow");

struct Params {
  const float* x; const int* pos; const float* mix_norm; const float* w_in; const float* conv_w; const float* b_i; const float* b_f;
  const float* head_norm; const float* q_a_norm; const float* w_uq; const float* kv_a_norm; const float* w_ukv; const float* q_norm;
  const float* k_norm; const float* w_branch; const float* w_out; const float* mlp_norm; const float* w_up; const float* w_down;
  float* out; unsigned char* ws;
};

__device__ __forceinline__ unsigned pk2(float lo, float hi) { unsigned r; asm("v_cvt_pk_bf16_f32 %0, %1, %2" : "=v"(r) : "v"(lo), "v"(hi)); return r; }
__device__ __forceinline__ bf16_t f2bf(float f) { return (bf16_t)(pk2(f, 0.f) & 0xffffu); }
__device__ __forceinline__ float bf2f(bf16_t h) { return __uint_as_float(((unsigned)h) << 16); }
__device__ __forceinline__ float bflo(unsigned u) { return __uint_as_float(u << 16); }
__device__ __forceinline__ float bfhi(unsigned u) { return __uint_as_float(u & 0xffff0000u); }
__device__ __forceinline__ void st4bf(bf16_t* ptr, float a, float b, float c, float d) { uint2 v; v.x = pk2(a, b); v.y = pk2(c, d); *(uint2*)ptr = v; }
__device__ __forceinline__ float red4(float v) { v += __shfl_xor(v, 16); v += __shfl_xor(v, 32); return v; }
__device__ __forceinline__ float sigmoidf_(float x) { return 1.f / (1.f + __expf(-x)); }
__device__ __forceinline__ int swz8(int row, int ch) { return row * 128 + ((ch ^ ((row >> 1) & 7)) << 4); }
__device__ __forceinline__ int swz16(int row, int ch) { return row * 256 + ((ch ^ (row & 15)) << 4); }
__device__ __forceinline__ int otid() { int t = threadIdx.x & 255; asm volatile("" : "+v"(t)); return t; }
__device__ __forceinline__ unsigned char* ows(unsigned char* w) { unsigned z = 0; asm volatile("" : "+s"(z)); return w + z; }
__device__ __forceinline__ int otid512() { int t = threadIdx.x; asm volatile("" : "+v"(t)); return t; }
__device__ __forceinline__ int ohalf() { return __builtin_amdgcn_readfirstlane((int)(threadIdx.x >> 8)); }
__device__ __forceinline__ void st_pair(bf16_t* p, const f32x4 a, const f32x4 b, int lg) {
  const unsigned a0 = pk2(a[0], a[1]), a1 = pk2(a[2], a[3]), b0 = pk2(b[0], b[1]), b1 = pk2(b[2], b[3]);
  const bool odd = lg & 1;
  const unsigned s0 = odd ? a0 : b0, s1 = odd ? a1 : b1, k0 = odd ? b0 : a0, k1 = odd ? b1 : a1;
  const unsigned r0 = (unsigned)__shfl_xor((int)s0, 16), r1 = (unsigned)__shfl_xor((int)s1, 16);
  uint4 o;
  o.x = odd ? r0 : k0; o.y = odd ? r1 : k1; o.z = odd ? k0 : r0; o.w = odd ? k1 : r1;
  *(uint4*)(p + (odd ? 16 + (lg - 1) * 4 : lg * 4)) = o;
}
#define MFMA(a, b, c) __builtin_amdgcn_mfma_f32_16x16x32_bf16((a), (b), (c), 0, 0, 0)

template <int WM, int WN>
__device__ __forceinline__ void gemm_core(const bf16_t* __restrict__ A, int lda, const bf16_t* __restrict__ B, int ldb, int K,
                                          unsigned char* lds, f32x4 (&acc)[8 / WM][8 / WN]) {
  constexpr int MT = 8 / WM, NT = 8 / WN, RM = 128 / WM, RN = 128 / WN;
  const int tid = otid(), lane = tid & 63, wid = tid >> 6, wr = wid / WN, wc = wid % WN, l15 = lane & 15, lg = lane >> 4;
  const int lrow = tid >> 3, lch = tid & 7;
#pragma unroll
  for (int mt = 0; mt < MT; ++mt)
#pragma unroll
    for (int nt = 0; nt < NT; ++nt) acc[mt][nt] = (f32x4){0.f, 0.f, 0.f, 0.f};
  const bf16_t* Ap = A + (size_t)lrow * lda + lch * 8;
  const bf16_t* Bp = B + (size_t)lrow * ldb + lch * 8;
  const size_t sa = (size_t)32 * lda, sb = (size_t)32 * ldb;
  const int so0 = swz8(lrow, lch);
  uint4 pa0, pa1, pa2, pa3, pb0, pb1, pb2, pb3;
  uint4 qa0, qa1, qa2, qa3, qb0, qb1, qb2, qb3;
#define G_LOAD(S, kt_) do { const bf16_t* a2 = Ap + (kt_) * 64; const bf16_t* b2 = Bp + (kt_) * 64; \
    S##a0 = *(const uint4*)(a2); S##a1 = *(const uint4*)(a2 + sa); S##a2 = *(const uint4*)(a2 + 2 * sa); S##a3 = *(const uint4*)(a2 + 3 * sa); \
    S##b0 = *(const uint4*)(b2); S##b1 = *(const uint4*)(b2 + sb); S##b2 = *(const uint4*)(b2 + 2 * sb); S##b3 = *(const uint4*)(b2 + 3 * sb); } while (0)
#define G_STORE(S, buf_) do { unsigned char* d_ = lds + (buf_) * 32768 + so0; \
    *(uint4*)(d_) = S##a0; *(uint4*)(d_ + 4096) = S##a1; *(uint4*)(d_ + 8192) = S##a2; *(uint4*)(d_ + 12288) = S##a3; \
    *(uint4*)(d_ + 16384) = S##b0; *(uint4*)(d_ + 20480) = S##b1; *(uint4*)(d_ + 24576) = S##b2; *(uint4*)(d_ + 28672) = S##b3; } while (0)
#define G_COMPUTE(buf_) do { const unsigned char* cur = lds + (buf_) * 32768; \
    const unsigned char* ab = cur + swz8(wr * RM + l15, lg); const unsigned char* bb = cur + 16384 + swz8(wc * RN + l15, lg); \
    const int kx = swz8(l15, 4 + lg) - swz8(l15, lg); \
    bf16x8 a0[MT], b0[NT], a1[MT], b1[NT]; \
    _Pragma("unroll") for (int mt = 0; mt < MT; ++mt) a0[mt] = *(const bf16x8*)(ab + mt * 2048); \
    _Pragma("unroll") for (int nt = 0; nt < NT; ++nt) b0[nt] = *(const bf16x8*)(bb + nt * 2048); \
    __builtin_amdgcn_sched_barrier(0); \
    _Pragma("unroll") for (int mt = 0; mt < MT; ++mt) a1[mt] = *(const bf16x8*)(ab + kx + mt * 2048); \
    _Pragma("unroll") for (int nt = 0; nt < NT; ++nt) b1[nt] = *(const bf16x8*)(bb + kx + nt * 2048); \
    __builtin_amdgcn_sched_barrier(0); \
    _Pragma("unroll") for (int mt = 0; mt < MT; ++mt) \
      _Pragma("unroll") for (int nt = 0; nt < NT; ++nt) acc[mt][nt] = MFMA(b0[nt], a0[mt], acc[mt][nt]); \
    __builtin_amdgcn_sched_barrier(0); \
    _Pragma("unroll") for (int mt = 0; mt < MT; ++mt) \
      _Pragma("unroll") for (int nt = 0; nt < NT; ++nt) acc[mt][nt] = MFMA(b1[nt], a1[mt], acc[mt][nt]); \
    } while (0)
  const int nk = K >> 6;
  G_LOAD(p, 0);
  G_LOAD(q, 1);
  G_STORE(p, 0);
  __syncthreads();
  for (int kt = 0; kt < nk; kt += 2) {
    const int k2 = kt + 2 < nk ? kt + 2 : kt;
    G_LOAD(p, k2);
    __builtin_amdgcn_sched_barrier(0);
    G_COMPUTE(0);
    __builtin_amdgcn_sched_barrier(0);
    G_STORE(q, 1);
    __syncthreads();
    G_LOAD(q, k2 + 1);
    __builtin_amdgcn_sched_barrier(0);
    G_COMPUTE(1);
    __builtin_amdgcn_sched_barrier(0);
    G_STORE(p, 0);
    __syncthreads();
  }
#undef G_LOAD
#undef G_STORE
#undef G_COMPUTE
}

#define STG_DECL uint4 st_a0, st_a1, st_a2, st_a3, st_b0, st_b1, st_b2, st_b3
#define STG_ARGS st_a0, st_a1, st_a2, st_a3, st_b0, st_b1, st_b2, st_b3
#define STG_PARAMS uint4& st_a0, uint4& st_a1, uint4& st_a2, uint4& st_a3, uint4& st_b0, uint4& st_b1, uint4& st_b2, uint4& st_b3
__device__ __forceinline__ void g256_issue(STG_PARAMS, const bf16_t* __restrict__ A, int lda, const bf16_t* __restrict__ B, int ldb) {
  const int tid = otid512(), lrow = tid >> 3, lch = tid & 7;
  const bf16_t* a2 = A + (size_t)lrow * lda + lch * 8; const bf16_t* b2 = B + (size_t)lrow * ldb + lch * 8;
  const size_t sa = (size_t)64 * lda, sb = (size_t)64 * ldb;
  st_a0 = *(const uint4*)(a2); st_a1 = *(const uint4*)(a2 + sa); st_a2 = *(const uint4*)(a2 + 2 * sa); st_a3 = *(const uint4*)(a2 + 3 * sa);
  st_b0 = *(const uint4*)(b2); st_b1 = *(const uint4*)(b2 + sb); st_b2 = *(const uint4*)(b2 + 2 * sb); st_b3 = *(const uint4*)(b2 + 3 * sb);
}
__device__ __forceinline__ void gemm256(const bf16_t* __restrict__ A, int lda, const bf16_t* __restrict__ B, int ldb, int K, unsigned char* lds, f32x4 (&acc)[8][4], STG_PARAMS) {
  const int tid = otid512(), lane = tid & 63, wid = tid >> 6, wr = wid >> 2, wc = wid & 3, l15 = lane & 15, lg = lane >> 4;
  const int lrow = tid >> 3, lch = tid & 7;
#pragma unroll
  for (int mt = 0; mt < 8; ++mt)
#pragma unroll
    for (int nt = 0; nt < 4; ++nt) acc[mt][nt] = (f32x4){0.f, 0.f, 0.f, 0.f};
  const bf16_t* Ap = A + (size_t)lrow * lda + lch * 8;
  const bf16_t* Bp = B + (size_t)lrow * ldb + lch * 8;
  const size_t sa = (size_t)64 * lda, sb = (size_t)64 * ldb;
  const int so0 = swz8(lrow, lch);
  uint4 &pa0 = st_a0, &pa1 = st_a1, &pa2 = st_a2, &pa3 = st_a3, &pb0 = st_b0, &pb1 = st_b1, &pb2 = st_b2, &pb3 = st_b3;
#define H_LOAD(kt_) do { const bf16_t* a2 = Ap + (kt_) * 64; const bf16_t* b2 = Bp + (kt_) * 64; \
    pa0 = *(const uint4*)(a2); pa1 = *(const uint4*)(a2 + sa); pa2 = *(const uint4*)(a2 + 2 * sa); pa3 = *(const uint4*)(a2 + 3 * sa); \
    pb0 = *(const uint4*)(b2); pb1 = *(const uint4*)(b2 + sb); pb2 = *(const uint4*)(b2 + 2 * sb); pb3 = *(const uint4*)(b2 + 3 * sb); } while (0)
#define H_STORE(buf_) do { unsigned char* d_ = lds + (buf_) * 65536 + so0; \
    *(uint4*)(d_) = pa0; *(uint4*)(d_ + 8192) = pa1; *(uint4*)(d_ + 16384) = pa2; *(uint4*)(d_ + 24576) = pa3; \
    *(uint4*)(d_ + 32768) = pb0; *(uint4*)(d_ + 40960) = pb1; *(uint4*)(d_ + 49152) = pb2; *(uint4*)(d_ + 57344) = pb3; } while (0)
  const int nk = K >> 6;
  H_STORE(0);
  H_LOAD(1);
  __syncthreads();
  for (int kt = 0; kt < nk; ++kt) {
    const unsigned char* cur = lds + (kt & 1) * 65536;
    unsigned char* nx_ = lds + ((kt + 1) & 1) * 65536 + so0;
    const int k2 = kt + 2 < nk ? kt + 2 : kt;
    const bf16_t* a2 = Ap + k2 * 64; const bf16_t* b2 = Bp + k2 * 64;
#define RS_A(r, i) do { *(uint4*)(nx_ + (i) * 8192) = r; r = *(const uint4*)(a2 + (i) * sa); } while (0)
#define RS_B(r, i) do { *(uint4*)(nx_ + 32768 + (i) * 8192) = r; r = *(const uint4*)(b2 + (i) * sb); } while (0)
    {
      const unsigned char* ab = cur + swz8(wr * 128 + l15, lg);
      const unsigned char* bb = cur + 32768 + swz8(wc * 64 + l15, lg);
      const int kx = (swz8(l15, 4 + lg) - swz8(l15, lg));
      bf16x8 b0[4], b1[4], aA[4], aB[4];
#define LDB(dst, off) _Pragma("unroll") for (int nt = 0; nt < 4; ++nt) dst[nt] = *(const bf16x8*)(bb + (off) + nt * 2048)
#define LDA(dst, off, mh) _Pragma("unroll") for (int m = 0; m < 4; ++m) dst[m] = *(const bf16x8*)(ab + (off) + ((mh) * 4 + m) * 2048)
#define MMA(aX, bX, mh) _Pragma("unroll") for (int m = 0; m < 4; ++m) _Pragma("unroll") for (int nt = 0; nt < 4; ++nt) acc[(mh) * 4 + m][nt] = MFMA(bX[nt], aX[m], acc[(mh) * 4 + m][nt])
      LDB(b0, 0); LDA(aA, 0, 0);
      __builtin_amdgcn_sched_barrier(0);
      LDA(aB, 0, 1);
      RS_A(pa0, 0); RS_A(pa1, 1); RS_A(pa2, 2);
      __builtin_amdgcn_sched_barrier(0);
      MMA(aA, b0, 0);
      __builtin_amdgcn_sched_barrier(0);
      LDB(b1, kx); LDA(aA, kx, 0);
      RS_A(pa3, 3); RS_B(pb0, 0); RS_B(pb1, 1);
      __builtin_amdgcn_sched_barrier(0);
      MMA(aB, b0, 1);
      __builtin_amdgcn_sched_barrier(0);
      LDA(aB, kx, 1);
      RS_B(pb2, 2); RS_B(pb3, 3);
      __builtin_amdgcn_sched_barrier(0);
      MMA(aA, b1, 0);
      __builtin_amdgcn_sched_barrier(0);
      MMA(aB, b1, 1);
#undef LDB
#undef LDA
#undef MMA
    }
#undef RS_A
#undef RS_B
    __builtin_amdgcn_sched_barrier(0);
    __syncthreads();
  }
#undef H_LOAD
#undef H_STORE
}

__device__ __forceinline__ int map_in(int n) {
  if (n < 6144) return n;
  if (n < 6592) return n + 16;
  if (n < 6608) return n - 448;
  if (n < 6656) return -1;
  return n - 48;
}
__device__ __forceinline__ int map_uq(int n) { return n < 1024 ? (n >> 7) * 192 + (n & 127) : ((n - 1024) >> 6) * 192 + 128 + ((n - 1024) & 63); }
__device__ __forceinline__ int map_ukv(int n) { return n < 1024 ? (n >> 7) * 256 + (n & 127) : ((n - 1024) >> 7) * 256 + 128 + ((n - 1024) & 127); }

__device__ __forceinline__ void transpose_tile(const float* __restrict__ W, int NO, int K, bf16_t* __restrict__ out, int N, int MAP, const float* __restrict__ gain,
                               int tile, float* ldsf) {
  const int ntn = N >> 6, n0 = (tile % ntn) << 6, k0 = (tile / ntn) << 6;
  const int tl = threadIdx.x & 255;
  {
    const int r = tl >> 4, c4 = (tl & 15) * 4, n = n0 + c4;
    const int o = MAP == 0 ? n : MAP == 1 ? map_in(n) : MAP == 2 ? map_uq(n) : map_ukv(n);
#pragma unroll
    for (int i = 0; i < 4; ++i) {
      const int k = k0 + r + 16 * i;
      float4 v = o >= 0 ? *(const float4*)(W + (size_t)k * NO + o) : make_float4(0.f, 0.f, 0.f, 0.f);
      if (gain) { const float g = gain[k]; v.x *= g; v.y *= g; v.z *= g; v.w *= g; }
      *(float4*)(ldsf + (r + 16 * i) * 68 + c4) = v;
    }
  }
  __syncthreads();
  {
    const int nn = tl >> 2, kq = tl & 3;
#pragma unroll
    for (int j = 0; j < 2; ++j) {
      const int kk = (kq + 4 * j) * 8;
      uint4 o;
      o.x = pk2(ldsf[(kk + 0) * 68 + nn], ldsf[(kk + 1) * 68 + nn]); o.y = pk2(ldsf[(kk + 2) * 68 + nn], ldsf[(kk + 3) * 68 + nn]);
      o.z = pk2(ldsf[(kk + 4) * 68 + nn], ldsf[(kk + 5) * 68 + nn]); o.w = pk2(ldsf[(kk + 6) * 68 + nn], ldsf[(kk + 7) * 68 + nn]);
      *(uint4*)(out + (size_t)(n0 + nn) * K + k0 + kk) = o;
    }
  }
  __syncthreads();
}

__device__ __forceinline__ void prologue(const Params& p, unsigned char* lds) {
  const int half = ohalf();
  float* ldsf = (float*)(lds + half * LDS_BYTES);
  unsigned char* ws = ows(p.ws);
  const int G = 2 * gridDim.x, bid = 2 * blockIdx.x + half, tid = threadIdx.x & 255;
  constexpr int TL = 2432 + 96 + 64 + 768 + 256 + 1024 + 1024;
  for (int it = bid; it < 2 * TL; it += G) {
    const int l = it / TL; int r = it % TL;
    if (r < 2432) { transpose_tile(p.w_in + (size_t)l * 1024 * NIN_O, NIN_O, 1024, (bf16_t*)(ws + OFF_WIN + l * SZ_WIN), NIN, 1, p.mix_norm + l * 1024, r, ldsf); continue; }
    r -= 2432;
    if (r < 96) { transpose_tile(p.w_uq + (size_t)l * 256 * 1536, 1536, 256, (bf16_t*)(ws + OFF_WUQ + l * SZ_WUQ), 1536, 2, p.q_a_norm + l * 256, r, ldsf); continue; }
    r -= 96;
    if (r < 64) { transpose_tile(p.w_ukv + (size_t)l * 128 * 2048, 2048, 128, (bf16_t*)(ws + OFF_WUKV + l * SZ_WUKV), 2048, 3, p.kv_a_norm + l * 128, r, ldsf); continue; }
    r -= 64;
    if (r < 768) { const int br = r >> 8; transpose_tile(p.w_branch + ((size_t)l * 3 + br) * 1024 * 1024, 1024, 1024, (bf16_t*)(ws + OFF_WBR + l * SZ_WBR) + (size_t)br * 1024 * 1024, 1024, 0, nullptr, r & 255, ldsf); continue; }
    r -= 768;
    if (r < 256) { transpose_tile(p.w_out + (size_t)l * 1024 * 1024, 1024, 1024, (bf16_t*)(ws + OFF_WOUT + l * SZ_WOUT), 1024, 0, nullptr, r, ldsf); continue; }
    r -= 256;
    if (r < 1024) { transpose_tile(p.w_up + (size_t)l * 1024 * 4096, 4096, 1024, (bf16_t*)(ws + OFF_WUP + l * SZ_WUP), 4096, 0, p.mlp_norm + l * 1024, r, ldsf); continue; }
    r -= 1024;
    transpose_tile(p.w_down + (size_t)l * 4096 * 1024, 1024, 4096, (bf16_t*)(ws + OFF_WDN + l * SZ_WDN), 1024, 0, nullptr, r, ldsf);
  }
  {
    bf16_t* XB = (bf16_t*)(ws + OFF_XB); float* SSX = (float*)(ws + OFF_SSX);
    for (int it = bid; it < 16384; it += G) {
      const int t = it * 2 + (tid >> 7), c = (tid & 127) * 8;
      const float4 a = *(const float4*)(p.x + (size_t)t * 1024 + c), b = *(const float4*)(p.x + (size_t)t * 1024 + c + 4);
      uint4 o; o.x = pk2(a.x, a.y); o.y = pk2(a.z, a.w); o.z = pk2(b.x, b.y); o.w = pk2(b.z, b.w);
      *(uint4*)(XB + (size_t)t * 1024 + c) = o;
      float s = a.x * a.x + a.y * a.y + a.z * a.z + a.w * a.w + b.x * b.x + b.y * b.y + b.z * b.z + b.w * b.w;
      s += __shfl_xor(s, 1); s += __shfl_xor(s, 2); s += __shfl_xor(s, 4);
      if ((tid & 7) == 0) SSX[(size_t)t * 16 + (c >> 6)] = s;
    }
  }
  {
    float* COS = (float*)(ws + OFF_COS); float* SIN = (float*)(ws + OFF_SIN);
    for (int it = bid; it < 4096; it += G) {
      const int e = it * 256 + tid, t = e >> 5, i = e & 31;
      const float invf = (float)exp(-(double)i * (9.210340371976184 / 32.0));
      const float ang = (float)p.pos[t] * invf;
      double a = (double)ang;
      const double n = rint(a * 0.15915494309189535);
      double r = a - n * 6.283185307179586477;
      const double r2 = r * r;
      double sn = 1.0 / 1.5511210043330986e25, cs = 1.0 / 6.2044840173323944e23;
      sn = 1.0 / 2.5852016738884978e22 - sn * r2; cs = 1.0 / 1.1240007277776077e21 - cs * r2;
      sn = 1.0 / 5.109094217170944e19 - sn * r2;  cs = 1.0 / 2.43290200817664e18 - cs * r2;
      sn = 1.0 / 1.21645100408832e17 - sn * r2;   cs = 1.0 / 6.402373705728e15 - cs * r2;
      sn = 1.0 / 3.55687428096e14 - sn * r2;      cs = 1.0 / 2.0922789888e13 - cs * r2;
      sn = 1.0 / 1.307674368e12 - sn * r2;        cs = 1.0 / 8.71782912e10 - cs * r2;
      sn = 1.0 / 6227020800.0 - sn * r2;          cs = 1.0 / 479001600.0 - cs * r2;
      sn = 1.0 / 39916800.0 - sn * r2;            cs = 1.0 / 3628800.0 - cs * r2;
      sn = 1.0 / 362880.0 - sn * r2;              cs = 1.0 / 40320.0 - cs * r2;
      sn = 1.0 / 5040.0 - sn * r2;                cs = 1.0 / 720.0 - cs * r2;
      sn = 1.0 / 120.0 - sn * r2;                 cs = 1.0 / 24.0 - cs * r2;
      sn = 1.0 / 6.0 - sn * r2;                   cs = 1.0 / 2.0 - cs * r2;
      sn = 1.0 - sn * r2;                         cs = 1.0 - cs * r2;
      sn *= r;
      COS[e] = (float)cs; SIN[e] = (float)sn;
    }
  }
}

__device__ __forceinline__ void phase1(const Params& p, int l, int b, unsigned char* lds) {
  unsigned char* ws = ows(p.ws);
  const bf16_t* XB = (const bf16_t*)(ws + OFF_XB) + (size_t)b * TR * 1024;
  const float* SSX = (const float*)(ws + OFF_SSX) + (size_t)b * TR * 16;
  const float* COS = (const float*)(ws + OFF_COS) + (size_t)b * TR * 32;
  const float* SIN = (const float*)(ws + OFF_SIN) + (size_t)b * TR * 32;
  const bf16_t* WT = (const bf16_t*)(ws + OFF_WIN + l * SZ_WIN);
  bf16_t* CONV = (bf16_t*)(ws + OFF_CONV); bf16_t* GATES = (bf16_t*)(ws + OFF_GATES);
  bf16_t* MQ = (bf16_t*)(ws + OFF_MQ); bf16_t* MK = (bf16_t*)(ws + OFF_MK); bf16_t* MVT = (bf16_t*)(ws + OFF_MVT); bf16_t* MO = (bf16_t*)(ws + OFF_MO);
  float* MIF = (float*)(ws + OFF_MIF); bf16_t* CQ = (bf16_t*)(ws + OFF_CQ); bf16_t* CKV = (bf16_t*)(ws + OFF_CKV);
  float* SSCQ = (float*)(ws + OFF_SSCQ); float* SSCKV = (float*)(ws + OFF_SSCKV); bf16_t* KB = (bf16_t*)(ws + OFF_K);
  const float* knorm = p.k_norm + l * 192;
  STG_DECL;
  { const int t0 = blockIdx.x < 32 * 38 ? blockIdx.x : 0; g256_issue(STG_ARGS, XB + (size_t)(t0 & 31) * 256 * 1024, 1024, WT + (size_t)(t0 >> 5) * 256 * 1024, 1024); }
  for (int tile = blockIdx.x; tile < 32 * 38; tile += gridDim.x) {
    const int mtile = tile & 31, ntile = tile >> 5;
    f32x4 acc[8][4];
    gemm256(XB + (size_t)mtile * 256 * 1024, 1024, WT + (size_t)ntile * 256 * 1024, 1024, 1024, lds, acc, STG_ARGS);
    const int tix = otid512(), lane = tix & 63, wid = tix >> 6, l15 = lane & 15, lg = lane >> 4;
    const int rbase = mtile * 256 + (wid >> 2) * 128;
    const int colw = __builtin_amdgcn_readfirstlane(ntile * 256 + (wid & 3) * 64);
#pragma unroll
    for (int mt = 0; mt < 8; ++mt) {
      const float4* sp = (const float4*)(SSX + (size_t)(rbase + mt * 16 + l15) * 16);
      const float4 a = sp[0], b2 = sp[1], c = sp[2], d = sp[3];
      const float s = (a.x + a.y + a.z + a.w) + (b2.x + b2.y + b2.z + b2.w) + (c.x + c.y + c.z + c.w) + (d.x + d.y + d.z + d.w);
      const float rs = rsqrtf(s * (1.f / 1024.f) + EPS);
#pragma unroll
      for (int nt = 0; nt < 4; ++nt) acc[mt][nt] *= rs;
    }
    {
      const int nx = tile + (int)gridDim.x < 32 * 38 ? tile + (int)gridDim.x : tile;
      g256_issue(STG_ARGS, XB + (size_t)(nx & 31) * 256 * 1024, 1024, WT + (size_t)(nx >> 5) * 256 * 1024, 1024);
    }
    if (colw < 3072 || (colw >= 5120 && colw < 6144) || colw >= 6656) {
      bf16_t* dst; int ld, c0;
      if (colw < 3072) { dst = CONV; ld = 3072; c0 = colw; }
      else if (colw < 6144) { dst = MO; ld = 1024; c0 = colw - 5120; }
      else { dst = GATES; ld = 3072; c0 = colw - 6656; }
      const bool sg = colw >= 6656;
#pragma unroll
      for (int mt = 0; mt < 8; ++mt) {
        if (sg) {
#pragma unroll
          for (int nt = 0; nt < 4; ++nt) { f32x4 v = acc[mt][nt]; v[0] = sigmoidf_(v[0]); v[1] = sigmoidf_(v[1]); v[2] = sigmoidf_(v[2]); v[3] = sigmoidf_(v[3]); acc[mt][nt] = v; }
        }
        bf16_t* rp = dst + (size_t)(rbase + mt * 16 + l15) * ld + c0;
        st_pair(rp, acc[mt][0], acc[mt][1], lg); st_pair(rp + 32, acc[mt][2], acc[mt][3], lg);
      }
    } else if (colw < 4096) {
      bf16_t* dst = colw < 3584 ? MQ : MK; const int c0 = colw < 3584 ? colw - 3072 : colw - 3584; const float sc = colw < 3584 ? 0.125f : 1.f;
#pragma unroll
      for (int mt = 0; mt < 8; ++mt) {
        bf16_t* rp = dst + (size_t)(rbase + mt * 16 + l15) * 512 + c0;
        st_pair(rp, acc[mt][0] * sc, acc[mt][1] * sc, lg); st_pair(rp + 32, acc[mt][2] * sc, acc[mt][3] * sc, lg);
      }
    } else if (colw < 5120) {
      const int c0 = colw - 4096;
#pragma unroll
      for (int mt = 0; mt < 8; ++mt)
#pragma unroll
        for (int nt = 0; nt < 4; ++nt)
#pragma unroll
          for (int jj = 0; jj < 4; ++jj)
            MVT[(size_t)(c0 + nt * 16 + lg * 4 + jj) * TR + rbase + mt * 16 + l15] = f2bf(acc[mt][nt][jj]);
    } else if (colw < 6528) {
      const bool iscq = colw < 6400;
      bf16_t* dst = iscq ? CQ : CKV; const int ld = iscq ? 256 : 128; const int c0 = iscq ? colw - 6144 : colw - 6400;
#pragma unroll
      for (int mt = 0; mt < 8; ++mt) {
        float s = 0.f;
#pragma unroll
        for (int nt = 0; nt < 4; ++nt) {
          const f32x4 v = acc[mt][nt];
          s += v[0] * v[0] + v[1] * v[1] + v[2] * v[2] + v[3] * v[3];
        }
        { bf16_t* rp = dst + (size_t)(rbase + mt * 16 + l15) * ld + c0;
          st_pair(rp, acc[mt][0], acc[mt][1], lg); st_pair(rp + 32, acc[mt][2], acc[mt][3], lg); }
        s = red4(s);
        if (lg == 0) {
          const int row = rbase + mt * 16 + l15;
          if (iscq) SSCQ[row * 4 + (c0 >> 6)] = s; else SSCKV[row * 2 + (c0 >> 6)] = s;
        }
      }
    } else if (colw == 6528) {
#pragma unroll
      for (int mt = 0; mt < 8; ++mt) {
        const int row = rbase + mt * 16 + l15;
        float s = 0.f;
#pragma unroll
        for (int nt = 0; nt < 4; ++nt) { const f32x4 v = acc[mt][nt]; s += v[0] * v[0] + v[1] * v[1] + v[2] * v[2] + v[3] * v[3]; }
        s = red4(s);
        const float rn = rsqrtf(s * (1.f / 64.f) + EPS);
#pragma unroll
        for (int nt = 0; nt < 2; ++nt) {
          const int c = nt * 16 + lg * 4;
          const float4 cs = *(const float4*)(COS + (size_t)row * 32 + c), sn = *(const float4*)(SIN + (size_t)row * 32 + c);
          const float4 g1 = *(const float4*)(knorm + 128 + c), g2 = *(const float4*)(knorm + 160 + c);
          const f32x4 a = acc[mt][nt], b2 = acc[mt][nt + 2];
          const float x10 = a[0] * rn * g1.x, x11 = a[1] * rn * g1.y, x12 = a[2] * rn * g1.z, x13 = a[3] * rn * g1.w;
          const float x20 = b2[0] * rn * g2.x, x21 = b2[1] * rn * g2.y, x22 = b2[2] * rn * g2.z, x23 = b2[3] * rn * g2.w;
          uint2 o1, o2;
          o1.x = pk2(x10 * cs.x - x20 * sn.x, x11 * cs.y - x21 * sn.y); o1.y = pk2(x12 * cs.z - x22 * sn.z, x13 * cs.w - x23 * sn.w);
          o2.x = pk2(x10 * sn.x + x20 * cs.x, x11 * sn.y + x21 * cs.y); o2.y = pk2(x12 * sn.z + x22 * cs.z, x13 * sn.w + x23 * cs.w);
#pragma unroll
          for (int h = 0; h < 8; ++h) {
            *(uint2*)(KB + ((size_t)row * 8 + h) * 192 + 128 + c) = o1;
            *(uint2*)(KB + ((size_t)row * 8 + h) * 192 + 160 + c) = o2;
          }
        }
      }
    } else {
#pragma unroll
      for (int mt = 0; mt < 8; ++mt) *(f32x4*)(MIF + (size_t)(rbase + mt * 16 + l15) * 16 + lg * 4) = acc[mt][0];
    }
  }
}

__device__ __forceinline__ void mlstm_gates(const float* __restrict__ MIF, int t0, int h, float bi, float bf, float* sB, float* sU, float* sCM) {
  const int tid = otid();
  if (tid < 128) {
    const float ip = MIF[(size_t)(t0 + tid) * 16 + h] + bi, fp = MIF[(size_t)(t0 + tid) * 16 + 8 + h] + bf;
    const float li = 15.f * tanhf(ip * (1.f / 15.f));
    const float fc = 15.f * tanhf(fp * (1.f / 15.f));
    const float lf = fminf(fc, 0.f) - log1pf(expf(-fabsf(fc)));
    sU[tid] = li; sB[tid] = lf;
  }
  __syncthreads();
  if (tid < 64) {
    const float f0 = sB[2 * tid], f1 = sB[2 * tid + 1], i0 = sU[2 * tid], i1 = sU[2 * tid + 1];
    float v = f0 + f1;
#pragma unroll
    for (int d = 1; d < 64; d <<= 1) { const float o = __shfl_up(v, d); if (tid >= d) v += o; }
    const float b1 = v, b0 = v - f1;
    const float u0 = i0 - b0, u1 = i1 - b1;
    float m = fmaxf(u0, u1);
#pragma unroll
    for (int d = 1; d < 64; d <<= 1) { const float o = __shfl_up(m, d); if (tid >= d) m = fmaxf(m, o); }
    float mprev = __shfl_up(m, 1); if (tid == 0) mprev = -INFINITY;
    sB[2 * tid] = b0; sB[2 * tid + 1] = b1; sU[2 * tid] = u0; sU[2 * tid + 1] = u1;
    sCM[2 * tid] = fmaxf(mprev, u0); sCM[2 * tid + 1] = m;
  }
  __syncthreads();
}

__device__ __forceinline__ void mlstm_local(const Params& p, int l, int h, int c, unsigned char* lds) {
  unsigned char* ws = ows(p.ws);
  const float* MIF = (const float*)(ws + OFF_MIF); const bf16_t* MK = (const bf16_t*)(ws + OFF_MK); const bf16_t* MVT = (const bf16_t*)(ws + OFF_MVT);
  float* CLOC = (float*)(ws + OFF_CLOC) + (size_t)(h * 64 + c) * 8192; float* NLOC = (float*)(ws + OFF_NLOC) + (h * 64 + c) * 64;
  float* sB = (float*)(lds + 65536); float* sU = sB + 128; float* sCM = sU + 128;
  const int tid = otid(), lane = tid & 63, w = tid >> 6, l15 = lane & 15, lg = lane >> 4, t0 = c * 128;
  mlstm_gates(MIF, t0, h, p.b_i[l * 8 + h], p.b_f[l * 8 + h], sB, sU, sCM);
  const float cml = sCM[127];
#pragma unroll
  for (int i = 0; i < 8; ++i) {
    const int cc = tid + i * 256, dv = cc >> 4, ch = cc & 15;
    *(uint4*)(lds + swz16(dv, ch)) = *(const uint4*)(MVT + (size_t)(h * 128 + dv) * TR + t0 + ch * 8);
  }
#pragma unroll
  for (int i = 0; i < 4; ++i) {
    const int cc = tid + i * 256, s = cc >> 3, kc = cc & 7;
    const uint4 kv = *(const uint4*)(MK + (size_t)(t0 + s) * 512 + h * 64 + kc * 8);
    const float wgt = __expf(sU[s] - cml);
    const unsigned u[4] = {kv.x, kv.y, kv.z, kv.w};
#pragma unroll
    for (int j = 0; j < 4; ++j) {
      const int k0 = kc * 8 + 2 * j;
      *(bf16_t*)(lds + 32768 + swz16(k0, s >> 3) + (s & 7) * 2) = f2bf(bflo(u[j]) * wgt);
      *(bf16_t*)(lds + 32768 + swz16(k0 + 1, s >> 3) + (s & 7) * 2) = f2bf(bfhi(u[j]) * wgt);
    }
  }
  __syncthreads();
  f32x4 acc[2][4];
#pragma unroll
  for (int dt = 0; dt < 2; ++dt)
#pragma unroll
    for (int kt = 0; kt < 4; ++kt) acc[dt][kt] = (f32x4){0.f, 0.f, 0.f, 0.f};
#pragma unroll
  for (int ss = 0; ss < 4; ++ss) {
    bf16x8 vf[2], kf[4];
#pragma unroll
    for (int dt = 0; dt < 2; ++dt) vf[dt] = *(const bf16x8*)(lds + swz16(w * 32 + dt * 16 + l15, ss * 4 + lg));
#pragma unroll
    for (int kt = 0; kt < 4; ++kt) kf[kt] = *(const bf16x8*)(lds + 32768 + swz16(kt * 16 + l15, ss * 4 + lg));
#pragma unroll
    for (int dt = 0; dt < 2; ++dt)
#pragma unroll
      for (int kt = 0; kt < 4; ++kt) acc[dt][kt] = MFMA(vf[dt], kf[kt], acc[dt][kt]);
  }
#pragma unroll
  for (int dt = 0; dt < 2; ++dt)
#pragma unroll
    for (int kt = 0; kt < 4; ++kt)
#pragma unroll
      for (int jj = 0; jj < 4; ++jj) CLOC[(w * 32 + dt * 16 + lg * 4 + jj) * 64 + kt * 16 + l15] = acc[dt][kt][jj];
  if (tid < 64) {
    float s = 0.f;
    for (int ch = 0; ch < 16; ++ch) {
      const uint4 v = *(const uint4*)(lds + 32768 + swz16(tid, ch));
      s += bflo(v.x) + bfhi(v.x) + bflo(v.y) + bfhi(v.y) + bflo(v.z) + bfhi(v.z) + bflo(v.w) + bfhi(v.w);
    }
    NLOC[tid] = s;
  }
  if (tid == 0) { ((float*)(ws + OFF_BL))[h * 64 + c] = sB[127]; ((float*)(ws + OFF_CMX))[h * 64 + c] = cml; }
  __syncthreads();
}

__device__ __forceinline__ void mlstm_scan(const Params& p, int item) {
  unsigned char* ws = ows(p.ws);
  const int h = item >> 5, sl = item & 31, tid = otid(), e = sl * 256 + tid;
  const float* CLOC = (const float*)(ws + OFF_CLOC) + (size_t)h * 64 * 8192; const float* NLOC = (const float*)(ws + OFF_NLOC) + h * 64 * 64;
  const float* BL = (const float*)(ws + OFF_BL) + h * 64; const float* CMX = (const float*)(ws + OFF_CMX) + h * 64;
  bf16_t* CPREV = (bf16_t*)(ws + OFF_CPREV) + (size_t)h * 64 * 8192; float* NPREV = (float*)(ws + OFF_NPREV) + h * 64 * 64; float* MPREV = (float*)(ws + OFF_MPREV) + h * 64;
  float cst = 0.f, nst = 0.f, m = 0.f;
  const bool do_n = (sl == 0 && tid < 64);
  for (int c0 = 0; c0 < 64; c0 += 16) {
    float cl[16], bl[16], cm[16], nl[16];
#pragma unroll
    for (int j = 0; j < 16; ++j) {
      cl[j] = CLOC[(size_t)(c0 + j) * 8192 + e]; bl[j] = BL[c0 + j]; cm[j] = CMX[c0 + j];
      nl[j] = do_n ? NLOC[(c0 + j) * 64 + tid] : 0.f;
    }
#pragma unroll
    for (int j = 0; j < 16; ++j) {
      const int c = c0 + j;
      CPREV[(size_t)c * 8192 + e] = f2bf(cst);
      if (do_n) NPREV[c * 64 + tid] = nst;
      if (sl == 0 && tid == 0) MPREV[c] = m;
      const float ml = bl[j] + cm[j];
      const float mn = fmaxf(bl[j] + m, ml), so = __expf(bl[j] + m - mn), sc = __expf(ml - mn);
      cst = so * cst + sc * cl[j];
      nst = so * nst + sc * nl[j];
      m = mn;
    }
  }
}

__device__ __forceinline__ void mlstm_out(const Params& p, int l, int h, int c, unsigned char* lds) {
  unsigned char* ws = ows(p.ws);
  const float* MIF = (const float*)(ws + OFF_MIF); const bf16_t* MQ = (const bf16_t*)(ws + OFF_MQ); const bf16_t* MK = (const bf16_t*)(ws + OFF_MK);
  const bf16_t* MVT = (const bf16_t*)(ws + OFF_MVT); const bf16_t* MO = (const bf16_t*)(ws + OFF_MO); bf16_t* YB = (bf16_t*)(ws + OFF_YB);
  const bf16_t* CPREV = (const bf16_t*)(ws + OFF_CPREV) + (size_t)(h * 64 + c) * 8192; const float* NPREV = (const float*)(ws + OFF_NPREV) + (h * 64 + c) * 64;
  const float mprev = ((const float*)(ws + OFF_MPREV))[h * 64 + c];
  const float* hn = p.head_norm + l * 1024 + h * 128;
  float* sB = (float*)(lds + 65536); float* sU = sB + 128; float* sCM = sU + 128; float* sN = sCM + 128;
  const int tid = otid(), lane = tid & 63, w = tid >> 6, l15 = lane & 15, lg = lane >> 4, t0 = c * 128;
  mlstm_gates(MIF, t0, h, p.b_i[l * 8 + h], p.b_f[l * 8 + h], sB, sU, sCM);
#pragma unroll
  for (int i = 0; i < 8; ++i) {
    const int cc = tid + i * 256, dv = cc >> 4, ch = cc & 15;
    *(uint4*)(lds + swz16(dv, ch)) = *(const uint4*)(MVT + (size_t)(h * 128 + dv) * TR + t0 + ch * 8);
  }
#pragma unroll
  for (int i = 0; i < 4; ++i) {
    const int cc = tid + i * 256, dv = cc >> 3, ch = cc & 7;
    *(uint4*)(lds + 49152 + swz8(dv, ch)) = *(const uint4*)(CPREV + dv * 64 + ch * 8);
  }
  if (tid < 64) sN[tid] = NPREV[tid];
  __syncthreads();
#pragma unroll
  for (int mt = 0; mt < 2; ++mt) {
    const int tl = w * 32 + mt * 16 + l15;
    const float Mt = fmaxf(mprev, sCM[tl]), inter = __expf(mprev - Mt), bt = sB[tl];
    bf16x8 qf[2];
#pragma unroll
    for (int ks = 0; ks < 2; ++ks) qf[ks] = *(const bf16x8*)(MQ + (size_t)(t0 + tl) * 512 + h * 64 + ks * 32 + lg * 8);
    f32x4 acc[8];
#pragma unroll
    for (int dt = 0; dt < 8; ++dt) acc[dt] = (f32x4){0.f, 0.f, 0.f, 0.f};
#pragma unroll
    for (int ks = 0; ks < 2; ++ks)
#pragma unroll
      for (int dt = 0; dt < 8; ++dt) {
        const bf16x8 cf = *(const bf16x8*)(lds + 49152 + swz8(dt * 16 + l15, ks * 4 + lg));
        acc[dt] = MFMA(cf, qf[ks], acc[dt]);
      }
    float dn = 0.f;
#pragma unroll
    for (int ks = 0; ks < 2; ++ks)
#pragma unroll
      for (int j = 0; j < 8; ++j) dn += bf2f((bf16_t)qf[ks][j]) * sN[ks * 32 + lg * 8 + j];
    dn = red4(dn) * inter;
#pragma unroll
    for (int dt = 0; dt < 8; ++dt) acc[dt] *= inter;
    const int ntmax = 2 * w + mt;
    f32x4 s[8];
    float rsum = 0.f;
#pragma unroll
    for (int nt = 0; nt < 8; ++nt) {
      s[nt] = (f32x4){0.f, 0.f, 0.f, 0.f};
      if (nt <= ntmax) {
#pragma unroll
        for (int ks = 0; ks < 2; ++ks) {
          const bf16x8 kf = *(const bf16x8*)(MK + (size_t)(t0 + nt * 16 + l15) * 512 + h * 64 + ks * 32 + lg * 8);
          s[nt] = MFMA(kf, qf[ks], s[nt]);
        }
#pragma unroll
        for (int jj = 0; jj < 4; ++jj) {
          const int sl = nt * 16 + lg * 4 + jj;
          const float wv = sl <= tl ? __expf(sU[sl] - Mt) : 0.f;
          const float pv = s[nt][jj] * wv;
          s[nt][jj] = pv; rsum += pv;
        }
      }
    }
    const float den = dn + red4(rsum);
#pragma unroll
    for (int kk = 0; kk < 4; ++kk) {
      if (2 * kk <= ntmax) {
        union { bf16x8 v; unsigned u[4]; } pf;
        pf.u[0] = pk2(s[2 * kk][0], s[2 * kk][1]); pf.u[1] = pk2(s[2 * kk][2], s[2 * kk][3]);
        pf.u[2] = pk2(s[2 * kk + 1][0], s[2 * kk + 1][1]); pf.u[3] = pk2(s[2 * kk + 1][2], s[2 * kk + 1][3]);
#pragma unroll
        for (int dt = 0; dt < 8; ++dt) {
          const int row = dt * 16 + l15;
          union { bf16x8 v; uint2 h2[2]; } vf;
          vf.h2[0] = *(const uint2*)(lds + swz16(row, kk * 4 + (lg >> 1)) + (lg & 1) * 8);
          vf.h2[1] = *(const uint2*)(lds + swz16(row, kk * 4 + 2 + (lg >> 1)) + (lg & 1) * 8);
          acc[dt] = MFMA(vf.v, pf.v, acc[dt]);
        }
      }
    }
    const float mt_ = bt + Mt;
    const float inv = 1.f / fmaxf(fabsf(den), __expf(-mt_));
    float ssq = 0.f;
#pragma unroll
    for (int dt = 0; dt < 8; ++dt) { acc[dt] *= inv; ssq += acc[dt][0] * acc[dt][0] + acc[dt][1] * acc[dt][1] + acc[dt][2] * acc[dt][2] + acc[dt][3] * acc[dt][3]; }
    ssq = red4(ssq);
    const float rn = rsqrtf(ssq * (1.f / 128.f) + EPS);
#pragma unroll
    for (int dt = 0; dt < 8; ++dt) {
      const int dv = dt * 16 + lg * 4;
      const float4 g = *(const float4*)(hn + dv);
      const uint2 og = *(const uint2*)(MO + (size_t)(t0 + tl) * 1024 + h * 128 + dv);
      st4bf(YB + (size_t)(t0 + tl) * 1024 + h * 128 + dv, acc[dt][0] * rn * g.x * sigmoidf_(bflo(og.x)), acc[dt][1] * rn * g.y * sigmoidf_(bfhi(og.x)),
            acc[dt][2] * rn * g.z * sigmoidf_(bflo(og.y)), acc[dt][3] * rn * g.w * sigmoidf_(bfhi(og.y)));
    }
  }
  __syncthreads();
}

__device__ __forceinline__ void conv_item(const Params& p, int l, int item) {
  unsigned char* ws = ows(p.ws);
  const bf16_t* CONV = (const bf16_t*)(ws + OFF_CONV); bf16_t* YA = (bf16_t*)(ws + OFF_YA);
  const float* cw = p.conv_w + l * 3 * 1024;
  const int tid = otid();
#pragma unroll 2
  for (int i = 0; i < 8; ++i) {
    const int cc = tid + i * 256, t = item * 16 + (cc >> 7), c = (cc & 127) * 8;
    const uint4 gb = *(const uint4*)(CONV + (size_t)t * 3072 + c);
    float z[3][8];
#pragma unroll
    for (int d = 0; d < 3; ++d) {
      const int tt = t - 2 + d;
      if (tt >= 0) {
        const uint4 a = *(const uint4*)(CONV + (size_t)tt * 3072 + 1024 + c), u = *(const uint4*)(CONV + (size_t)tt * 3072 + 2048 + c);
        z[d][0] = bflo(a.x) * bflo(u.x); z[d][1] = bfhi(a.x) * bfhi(u.x); z[d][2] = bflo(a.y) * bflo(u.y); z[d][3] = bfhi(a.y) * bfhi(u.y);
        z[d][4] = bflo(a.z) * bflo(u.z); z[d][5] = bfhi(a.z) * bfhi(u.z); z[d][6] = bflo(a.w) * bflo(u.w); z[d][7] = bfhi(a.w) * bfhi(u.w);
      } else {
#pragma unroll
        for (int j = 0; j < 8; ++j) z[d][j] = 0.f;
      }
    }
    float y[8];
#pragma unroll
    for (int j = 0; j < 8; ++j) y[j] = cw[c + j] * z[0][j] + cw[1024 + c + j] * z[1][j] + cw[2048 + c + j] * z[2][j];
    uint4 o;
    o.x = pk2(bflo(gb.x) * y[0], bfhi(gb.x) * y[1]); o.y = pk2(bflo(gb.y) * y[2], bfhi(gb.y) * y[3]);
    o.z = pk2(bflo(gb.z) * y[4], bfhi(gb.z) * y[5]); o.w = pk2(bflo(gb.w) * y[6], bfhi(gb.w) * y[7]);
    *(uint4*)(YA + (size_t)t * 1024 + c) = o;
  }
}

constexpr float QSCALE = 0.07216878364870322f * 1.4426950408889634f;

__device__ __forceinline__ void uq_tile(const Params& p, int l, int b, int tile, unsigned char* lds) {
  unsigned char* ws = ows(p.ws);
  const bf16_t* CQ = (const bf16_t*)(ws + OFF_CQ); const bf16_t* WT = (const bf16_t*)(ws + OFF_WUQ + l * SZ_WUQ);
  const float* SSCQ = (const float*)(ws + OFF_SSCQ); bf16_t* Q = (bf16_t*)(ws + OFF_Q);
  const float* COS = (const float*)(ws + OFF_COS) + (size_t)b * TR * 32; const float* SIN = (const float*)(ws + OFF_SIN) + (size_t)b * TR * 32;
  const float* qn = p.q_norm + l * 192;
  const int mtile = tile & 63, ntile = tile >> 6;
  const int tix = otid(), lane = tix & 63, wid = tix >> 6, l15 = lane & 15, lg = lane >> 4;
  f32x4 acc[2][8];
  gemm_core<4, 1>(CQ + (size_t)mtile * 128 * 256, 256, WT + (size_t)ntile * 128 * 256, 256, 256, lds, acc);
#pragma unroll
  for (int mt = 0; mt < 2; ++mt) {
    const int row = mtile * 128 + wid * 32 + mt * 16 + l15;
    const float4 sq = *(const float4*)(SSCQ + (size_t)row * 4);
    const float ra = rsqrtf((sq.x + sq.y + sq.z + sq.w) * (1.f / 256.f) + EPS);
#pragma unroll
    for (int nt = 0; nt < 8; ++nt) acc[mt][nt] *= ra;
    if (ntile < 8) {
      float s = 0.f;
#pragma unroll
      for (int nt = 0; nt < 8; ++nt) { const f32x4 v = acc[mt][nt]; s += v[0] * v[0] + v[1] * v[1] + v[2] * v[2] + v[3] * v[3]; }
      s = red4(s);
      const float rn = rsqrtf(s * (1.f / 128.f) + EPS) * QSCALE;
#pragma unroll
      for (int nt = 0; nt < 8; ++nt) {
        const int c = nt * 16 + lg * 4; const float4 g = *(const float4*)(qn + c); const f32x4 v = acc[mt][nt];
        st4bf(Q + ((size_t)row * 8 + ntile) * 192 + c, v[0] * rn * g.x, v[1] * rn * g.y, v[2] * rn * g.z, v[3] * rn * g.w);
      }
    } else {
#pragma unroll
      for (int hf = 0; hf < 2; ++hf) {
        const int h = (ntile - 8) * 2 + hf;
        float s = 0.f;
#pragma unroll
        for (int nt = 0; nt < 4; ++nt) { const f32x4 v = acc[mt][hf * 4 + nt]; s += v[0] * v[0] + v[1] * v[1] + v[2] * v[2] + v[3] * v[3]; }
        s = red4(s);
        const float rn = rsqrtf(s * (1.f / 64.f) + EPS);
#pragma unroll
        for (int nt = 0; nt < 2; ++nt) {
          const int c = nt * 16 + lg * 4;
          const float4 cs = *(const float4*)(COS + (size_t)row * 32 + c), sn = *(const float4*)(SIN + (size_t)row * 32 + c);
          const float4 g1 = *(const float4*)(qn + 128 + c), g2 = *(const float4*)(qn + 160 + c);
          const f32x4 a = acc[mt][hf * 4 + nt], b2 = acc[mt][hf * 4 + nt + 2];
          const float x10 = a[0] * rn * g1.x, x11 = a[1] * rn * g1.y, x12 = a[2] * rn * g1.z, x13 = a[3] * rn * g1.w;
          const float x20 = b2[0] * rn * g2.x, x21 = b2[1] * rn * g2.y, x22 = b2[2] * rn * g2.z, x23 = b2[3] * rn * g2.w;
          st4bf(Q + ((size_t)row * 8 + h) * 192 + 128 + c, (x10 * cs.x - x20 * sn.x) * QSCALE, (x11 * cs.y - x21 * sn.y) * QSCALE,
                (x12 * cs.z - x22 * sn.z) * QSCALE, (x13 * cs.w - x23 * sn.w) * QSCALE);
          st4bf(Q + ((size_t)row * 8 + h) * 192 + 160 + c, (x10 * sn.x + x20 * cs.x) * QSCALE, (x11 * sn.y + x21 * cs.y) * QSCALE,
                (x12 * sn.z + x22 * cs.z) * QSCALE, (x13 * sn.w + x23 * cs.w) * QSCALE);
        }
      }
    }
  }
}

__device__ __forceinline__ void ukv_tile(const Params& p, int l, int tile, unsigned char* lds) {
  unsigned char* ws = ows(p.ws);
  const bf16_t* CKV = (const bf16_t*)(ws + OFF_CKV); const bf16_t* WT = (const bf16_t*)(ws + OFF_WUKV + l * SZ_WUKV);
  const float* SSCKV = (const float*)(ws + OFF_SSCKV); bf16_t* KB = (bf16_t*)(ws + OFF_K); bf16_t* VT = (bf16_t*)(ws + OFF_VT);
  const float* kn = p.k_norm + l * 192;
  const int mtile = tile & 63, ntile = tile >> 6;
  const int tix = otid(), lane = tix & 63, wid = tix >> 6, l15 = lane & 15, lg = lane >> 4;
  f32x4 acc[2][8];
  gemm_core<4, 1>(CKV + (size_t)mtile * 128 * 128, 128, WT + (size_t)ntile * 128 * 128, 128, 128, lds, acc);
#pragma unroll
  for (int mt = 0; mt < 2; ++mt) {
    const int row = mtile * 128 + wid * 32 + mt * 16 + l15;
    const float ra = rsqrtf((SSCKV[row * 2] + SSCKV[row * 2 + 1]) * (1.f / 128.f) + EPS);
#pragma unroll
    for (int nt = 0; nt < 8; ++nt) acc[mt][nt] *= ra;
    if (ntile < 8) {
      float s = 0.f;
#pragma unroll
      for (int nt = 0; nt < 8; ++nt) { const f32x4 v = acc[mt][nt]; s += v[0] * v[0] + v[1] * v[1] + v[2] * v[2] + v[3] * v[3]; }
      s = red4(s);
      const float rn = rsqrtf(s * (1.f / 128.f) + EPS);
#pragma unroll
      for (int nt = 0; nt < 8; ++nt) {
        const int c = nt * 16 + lg * 4; const float4 g = *(const float4*)(kn + c); const f32x4 v = acc[mt][nt];
        st4bf(KB + ((size_t)row * 8 + ntile) * 192 + c, v[0] * rn * g.x, v[1] * rn * g.y, v[2] * rn * g.z, v[3] * rn * g.w);
      }
    } else {
      const int h = ntile - 8;
#pragma unroll
      for (int nt = 0; nt < 8; ++nt)
#pragma unroll
        for (int jj = 0; jj < 4; ++jj) VT[(size_t)(h * 128 + nt * 16 + lg * 4 + jj) * TR + row] = f2bf(acc[mt][nt][jj]);
    }
  }
}

__device__ __forceinline__ void attn_item(const Params& p, int h, int qb, unsigned char* lds0) {
  unsigned char* ws = ows(p.ws); const int half = ohalf(); unsigned char* lds = lds0 + half * LDS_BYTES;
  const bf16_t* Q = (const bf16_t*)(ws + OFF_Q); const bf16_t* KB = (const bf16_t*)(ws + OFF_K); const bf16_t* VT = (const bf16_t*)(ws + OFF_VT);
  bf16_t* YC = (bf16_t*)(ws + OFF_YC);
  const int tid = otid(), lane = tid & 63, w = __builtin_amdgcn_readfirstlane(tid >> 6), l15 = lane & 15, lg = lane >> 4;
  const int r0 = qb * 128 + 32 * w;
  const int fx = (l15 >> 1) & 7, fxc = (fx & 4) << 4;
  const int kfb = l15 * 384 + ((lg ^ (fx & 3)) << 4);
  const int kfe = kfb + fxc, kfo = kfb - fxc;
  const int vfb_ = 24576 + l15 * 128 + (lg & 1) * 8, vg = lg >> 1;
  const int vfa0 = vfb_ + (((0 | vg) ^ (fx & 3)) << 4) + (0 ^ fxc), vfa1 = vfb_ + (((0 | vg) ^ (fx & 3)) << 4) + (64 ^ fxc);
  const int vfb0 = vfb_ + (((2 | vg) ^ (fx & 3)) << 4) + (0 ^ fxc), vfb1 = vfb_ + (((2 | vg) ^ (fx & 3)) << 4) + (64 ^ fxc);
  bf16x8 qf[2][6];
#pragma unroll
  for (int mt = 0; mt < 2; ++mt)
#pragma unroll
    for (int ks = 0; ks < 6; ++ks) qf[mt][ks] = *(const bf16x8*)(Q + ((size_t)(r0 + mt * 16 + l15) * 8 + h) * 192 + ks * 32 + lg * 8);
  f32x4 o[2][8];
#pragma unroll
  for (int mt = 0; mt < 2; ++mt)
#pragma unroll
    for (int dt = 0; dt < 8; ++dt) o[mt][dt] = (f32x4){0.f, 0.f, 0.f, 0.f};
  float mrun[2] = {-INFINITY, -INFINITY}, lsum[2] = {0.f, 0.f};
  const int nh = qb + 1, kt0 = half, nkt = 2 * nh;
  const int skey = tid >> 2, sq = tid & 3, sx = (skey >> 1) & 7;
  const bf16_t* kp = KB + ((size_t)skey * 8 + h) * 192 + sq * 8;
  const int klb = skey * 384 + ((sq ^ (sx & 3)) << 4), kxc = (sx >> 2) << 6;
  const int vdv = tid >> 3, vch = tid & 7;
  const bf16_t* vp = VT + (size_t)(h * 128 + vdv) * TR + vch * 8;
  const int vlo0 = 24576 + swz8(vdv, vch);
  const bf16_t* kq = kp + (size_t)kt0 * 64 * 1536; const bf16_t* vq = vp + kt0 * 64;
  uint4 sk0 = *(const uint4*)kq, sk1 = *(const uint4*)(kq + 32), sk2 = *(const uint4*)(kq + 64), sk3 = *(const uint4*)(kq + 96), sk4 = *(const uint4*)(kq + 128), sk5 = *(const uint4*)(kq + 160);
  uint4 sv0 = *(const uint4*)vq, sv1 = *(const uint4*)(vq + (size_t)32 * TR), sv2 = *(const uint4*)(vq + (size_t)64 * TR), sv3 = *(const uint4*)(vq + (size_t)96 * TR);
  for (int kt = kt0; kt < nkt; kt += 2) {
    __syncthreads();
    *(uint4*)(lds + klb + (0 ^ kxc)) = sk0; *(uint4*)(lds + klb + (64 ^ kxc)) = sk1; *(uint4*)(lds + klb + (128 ^ kxc)) = sk2;
    *(uint4*)(lds + klb + (192 ^ kxc)) = sk3; *(uint4*)(lds + klb + (256 ^ kxc)) = sk4; *(uint4*)(lds + klb + (320 ^ kxc)) = sk5;
    *(uint4*)(lds + vlo0) = sv0; *(uint4*)(lds + vlo0 + 4096) = sv1; *(uint4*)(lds + vlo0 + 8192) = sv2; *(uint4*)(lds + vlo0 + 12288) = sv3;
    __syncthreads();
    {
      const int kn = kt + 2 < nkt ? kt + 2 : kt;
      const bf16_t* k2 = kp + (size_t)kn * 64 * 1536; const bf16_t* v2 = vp + kn * 64;
      sk0 = *(const uint4*)k2; sk1 = *(const uint4*)(k2 + 32); sk2 = *(const uint4*)(k2 + 64); sk3 = *(const uint4*)(k2 + 96); sk4 = *(const uint4*)(k2 + 128); sk5 = *(const uint4*)(k2 + 160);
      sv0 = *(const uint4*)v2; sv1 = *(const uint4*)(v2 + (size_t)32 * TR); sv2 = *(const uint4*)(v2 + (size_t)64 * TR); sv3 = *(const uint4*)(v2 + (size_t)96 * TR);
    }
    if (kt * 64 <= r0 + 31) {
      f32x4 s[2][4];
#pragma unroll
      for (int mt = 0; mt < 2; ++mt) {
        const float ni = mrun[mt] == -INFINITY ? 0.f : -mrun[mt];
#pragma unroll
        for (int nt = 0; nt < 4; ++nt) s[mt][nt] = (f32x4){ni, ni, ni, ni};
      }
#pragma unroll
      for (int ks = 0; ks < 6; ++ks) {
        bf16x8 kf[4];
#pragma unroll
        for (int nt = 0; nt < 4; ++nt) kf[nt] = *(const bf16x8*)(lds + ((ks & 1) ? kfo : kfe) + nt * 6144 + ks * 64);
#pragma unroll
        for (int mt = 0; mt < 2; ++mt)
#pragma unroll
          for (int nt = 0; nt < 4; ++nt) s[mt][nt] = MFMA(kf[nt], qf[mt][ks], s[mt][nt]);
      }
      if (kt * 64 + 63 > r0) {
#pragma unroll
        for (int mt = 0; mt < 2; ++mt)
#pragma unroll
          for (int nt = 0; nt < 4; ++nt)
#pragma unroll
            for (int jj = 0; jj < 4; ++jj)
              if (kt * 64 + nt * 16 + lg * 4 + jj > r0 + mt * 16 + l15) s[mt][nt][jj] = -INFINITY;
      }
      bf16x8 pf[2][2];
#pragma unroll
      for (int mt = 0; mt < 2; ++mt) {
        float mx = -INFINITY;
#pragma unroll
        for (int nt = 0; nt < 4; ++nt) mx = fmaxf(mx, fmaxf(fmaxf(s[mt][nt][0], s[mt][nt][1]), fmaxf(s[mt][nt][2], s[mt][nt][3])));
        mx = fmaxf(mx, __shfl_xor(mx, 16)); mx = fmaxf(mx, __shfl_xor(mx, 32));
        if (__any(mx > 8.f || mrun[mt] == -INFINITY)) {
          const float d = fmaxf(mx, 0.f);
          const float base = mrun[mt] == -INFINITY ? 0.f : mrun[mt];
          const float alpha = mrun[mt] == -INFINITY ? 0.f : __builtin_amdgcn_exp2f(-d);
          mrun[mt] = base + d;
          lsum[mt] *= alpha;
#pragma unroll
          for (int dt = 0; dt < 8; ++dt) o[mt][dt] *= alpha;
#pragma unroll
          for (int nt = 0; nt < 4; ++nt) s[mt][nt] -= d;
        }
        float rsum = 0.f;
#pragma unroll
        for (int nt = 0; nt < 4; ++nt)
#pragma unroll
          for (int jj = 0; jj < 4; ++jj) { const float pv = __builtin_amdgcn_exp2f(s[mt][nt][jj]); s[mt][nt][jj] = pv; rsum += pv; }
        lsum[mt] += rsum;
#pragma unroll
        for (int kk = 0; kk < 2; ++kk) {
          union { bf16x8 v; unsigned u[4]; } t;
          t.u[0] = pk2(s[mt][2 * kk][0], s[mt][2 * kk][1]); t.u[1] = pk2(s[mt][2 * kk][2], s[mt][2 * kk][3]);
          t.u[2] = pk2(s[mt][2 * kk + 1][0], s[mt][2 * kk + 1][1]); t.u[3] = pk2(s[mt][2 * kk + 1][2], s[mt][2 * kk + 1][3]);
          pf[mt][kk] = t.v;
        }
      }
#pragma unroll
      for (int kk = 0; kk < 2; ++kk)
#pragma unroll
        for (int dt = 0; dt < 8; ++dt) {

          union { bf16x8 v; uint2 h2[2]; } vf;
          vf.h2[0] = *(const uint2*)(lds + (kk ? vfa1 : vfa0) + dt * 2048);
          vf.h2[1] = *(const uint2*)(lds + (kk ? vfb1 : vfb0) + dt * 2048);
#pragma unroll
          for (int mt = 0; mt < 2; ++mt) o[mt][dt] = MFMA(vf.v, pf[mt][kk], o[mt][dt]);
        }
    }
  }
  __syncthreads();
  unsigned char* xr = lds0 + LDS_BYTES;
  if (half == 1) {
#pragma unroll
    for (int mt = 0; mt < 2; ++mt)
#pragma unroll
      for (int dt = 0; dt < 8; ++dt) *(f32x4*)(xr + ((mt * 8 + dt) * 256 + tid) * 16) = o[mt][dt];
    *(f32x4*)(xr + 65536 + tid * 16) = (f32x4){mrun[0], mrun[1], lsum[0], lsum[1]};
  }
  __syncthreads();
  if (half == 0) {
    const f32x4 ml = *(const f32x4*)(xr + 65536 + tid * 16);
#pragma unroll
    for (int mt = 0; mt < 2; ++mt) {
      const float m1 = ml[mt], l1 = ml[2 + mt];
      const float mn = fmaxf(mrun[mt], m1);
      const float a0 = __builtin_amdgcn_exp2f(mrun[mt] - mn), a1 = __builtin_amdgcn_exp2f(m1 - mn);
      const float inv = 1.f / red4(lsum[mt] * a0 + l1 * a1);
      const int row = r0 + mt * 16 + l15;
#pragma unroll
      for (int dt = 0; dt < 8; ++dt) {
        const f32x4 o1 = *(const f32x4*)(xr + ((mt * 8 + dt) * 256 + tid) * 16);
        o[mt][dt] = (o[mt][dt] * a0 + o1 * a1) * inv;
      }
#pragma unroll
      for (int dt = 0; dt < 8; dt += 2) st_pair(YC + (size_t)row * 1024 + h * 128 + dt * 16, o[mt][dt], o[mt][dt + 1], lg);
    }
  }
}

__device__ __forceinline__ void phase4(const Params& p, int l, unsigned char* lds0) {
  unsigned char* ws = ows(p.ws); const int half = ohalf(); unsigned char* lds = lds0 + half * LDS_BYTES;
  const bf16_t* Y = (const bf16_t*)(ws + OFF_YA); const bf16_t* WT = (const bf16_t*)(ws + OFF_WBR + l * SZ_WBR);
  const bf16_t* GATES = (const bf16_t*)(ws + OFF_GATES); bf16_t* MRG = (bf16_t*)(ws + OFF_MRG); float* MRGF = (float*)(ws + OFF_CONV);
  const int tix = otid(), lane = tix & 63, wid = tix >> 6, wr = wid >> 1, wc = wid & 1, l15 = lane & 15, lg = lane >> 4;
  for (int tile = 2 * blockIdx.x + half; tile < 64 * 8; tile += 2 * gridDim.x) {
    const int mtile = tile & 63, ntile = tile >> 6;
#pragma unroll 1
    for (int br = 0; br < 3; ++br) {
      f32x4 acc[4][4];
      gemm_core<2, 2>(Y + (size_t)br * TR * 1024 + (size_t)mtile * 128 * 1024, 1024, WT + (size_t)br * 1024 * 1024 + (size_t)ntile * 128 * 1024, 1024, 1024, lds, acc);
      const int t2 = otid(), ln2 = t2 & 63, w2 = t2 >> 6;
      const int row0 = mtile * 128 + (w2 >> 1) * 64 + (ln2 & 15), col0 = ntile * 128 + (w2 & 1) * 64 + (ln2 >> 4) * 4;
      const bf16_t* gp = GATES + (size_t)row0 * 3072 + br * 1024 + col0;
      float* fp = MRGF + (size_t)row0 * 1024 + col0;
      bf16_t* op = MRG + (size_t)row0 * 1024 + col0;
#pragma unroll
      for (int mt = 0; mt < 4; ++mt) {
#pragma unroll
        for (int nt = 0; nt < 4; ++nt) {
          const uint2 g = *(const uint2*)(gp + mt * 16 * 3072 + nt * 16);
          f32x4 v;
          v[0] = bflo(g.x) * acc[mt][nt][0]; v[1] = bfhi(g.x) * acc[mt][nt][1]; v[2] = bflo(g.y) * acc[mt][nt][2]; v[3] = bfhi(g.y) * acc[mt][nt][3];
          if (br > 0) v += *(const f32x4*)(fp + mt * 16 * 1024 + nt * 16);
          if (br < 2) *(f32x4*)(fp + mt * 16 * 1024 + nt * 16) = v; else st4bf(op + mt * 16 * 1024 + nt * 16, v[0], v[1], v[2], v[3]);
        }
        asm volatile("" ::: "memory");
      }
    }
  }
}

__device__ __forceinline__ void gemm_resid(const bf16_t* A, int K, const bf16_t* WT, const float* resid, float* R, bf16_t* XBo, float* SSo, unsigned char* lds0) {
  const int half = ohalf(); unsigned char* lds = lds0 + half * LDS_BYTES;
  const int tix = otid(), lane = tix & 63, wid = tix >> 6, wr = wid >> 1, wc = wid & 1, l15 = lane & 15, lg = lane >> 4;
  for (int tile = 2 * blockIdx.x + half; tile < 64 * 8; tile += 2 * gridDim.x) {
    const int mtile = tile & 63, ntile = tile >> 6;
    const int rbase = mtile * 128 + wr * 64, cbase = ntile * 128 + wc * 64;
    f32x4 acc[4][4];
    gemm_core<2, 2>(A + (size_t)mtile * 128 * K, K, WT + (size_t)ntile * 128 * K, K, K, lds, acc);
#pragma unroll
    for (int mt = 0; mt < 4; ++mt) {
      const int row = rbase + mt * 16 + l15;
      float s = 0.f;
#pragma unroll
      for (int nt = 0; nt < 4; ++nt) {
        const size_t off = (size_t)row * 1024 + cbase + nt * 16 + lg * 4;
        const f32x4 v = *(const f32x4*)(resid + off) + acc[mt][nt];
        *(f32x4*)(R + off) = v;
        acc[mt][nt] = v;
        if (XBo) s += v[0] * v[0] + v[1] * v[1] + v[2] * v[2] + v[3] * v[3];
      }
      if (XBo) { bf16_t* rp = XBo + (size_t)row * 1024 + cbase; st_pair(rp, acc[mt][0], acc[mt][1], lg); st_pair(rp + 32, acc[mt][2], acc[mt][3], lg); }
      if (XBo) { s = red4(s); if (lg == 0) SSo[(size_t)row * 16 + ntile * 2 + wc] = s; }
    }
  }
}

__device__ __forceinline__ void phase7(const Params& p, int l, unsigned char* lds) {
  unsigned char* ws = ows(p.ws);
  const bf16_t* XB1 = (const bf16_t*)(ws + OFF_XB1); const bf16_t* WT = (const bf16_t*)(ws + OFF_WUP + l * SZ_WUP);
  const float* SS1 = (const float*)(ws + OFF_SS1); bf16_t* H = (bf16_t*)(ws + OFF_H);
  STG_DECL;
  { const int t0 = blockIdx.x < 32 * 16 ? blockIdx.x : 0; g256_issue(STG_ARGS, XB1 + (size_t)(t0 & 31) * 256 * 1024, 1024, WT + (size_t)(t0 >> 5) * 256 * 1024, 1024); }
  for (int tile = blockIdx.x; tile < 32 * 16; tile += gridDim.x) {
    const int mtile = tile & 31, ntile = tile >> 5;
    f32x4 acc[8][4];
    gemm256(XB1 + (size_t)mtile * 256 * 1024, 1024, WT + (size_t)ntile * 256 * 1024, 1024, 1024, lds, acc, STG_ARGS);
    { const int nx = tile + (int)gridDim.x < 32 * 16 ? tile + (int)gridDim.x : tile;
      g256_issue(STG_ARGS, XB1 + (size_t)(nx & 31) * 256 * 1024, 1024, WT + (size_t)(nx >> 5) * 256 * 1024, 1024); }
    const int tix = otid512(), lane = tix & 63, wid = tix >> 6, l15 = lane & 15, lg = lane >> 4;
    const int rbase = mtile * 256 + (wid >> 2) * 128, cbase = ntile * 256 + (wid & 3) * 64;
#pragma unroll
    for (int mt = 0; mt < 8; ++mt) {
      const int row = rbase + mt * 16 + l15;
      const float4* sp = (const float4*)(SS1 + (size_t)row * 16);
      const float4 a = sp[0], b2 = sp[1], c = sp[2], d = sp[3];
      const float s = (a.x + a.y + a.z + a.w) + (b2.x + b2.y + b2.z + b2.w) + (c.x + c.y + c.z + c.w) + (d.x + d.y + d.z + d.w);
      const float r = rsqrtf(s * (1.f / 1024.f) + EPS);
#pragma unroll
      for (int nt = 0; nt < 4; ++nt) {
        f32x4 v = acc[mt][nt] * r;
#pragma unroll
        for (int jj = 0; jj < 4; ++jj) { const float t = fmaxf(v[jj], 0.f); v[jj] = t * t; }
        acc[mt][nt] = v;
      }
      { bf16_t* rp = H + (size_t)row * 4096 + cbase;
        st_pair(rp, acc[mt][0], acc[mt][1], lg); st_pair(rp + 32, acc[mt][2], acc[mt][3], lg); }
    }
  }
}

#define XB_TMO      128
#define XB_XCNT(j)  (256  + 64 * (j))
#define XB_XSUB(j)  (1280 + 64 * (j))
#define XB_XGEN(j)  (2304 + 64 * (j))
#define XB_TOP      3328
#define XB_TOPGEN   3392
#define XCD_BAR_WORDS 3456
#define XB_SPIN_CAP (1u << 18)
#define LAS __attribute__((address_space(3)))

__device__ __forceinline__ unsigned xb_ld(unsigned* p)              { return __hip_atomic_load(p, __ATOMIC_RELAXED, __HIP_MEMORY_SCOPE_AGENT); }
__device__ __forceinline__ unsigned xb_add(unsigned* p, unsigned v) { return __hip_atomic_fetch_add(p, v, __ATOMIC_RELAXED, __HIP_MEMORY_SCOPE_AGENT); }
__device__ __forceinline__ unsigned xb_xcc_id() { return (unsigned)__builtin_amdgcn_s_getreg((3 << 11) | 20) & 0xFu; }
#define XB_SPIN(cond, bar) do { unsigned _sp = 0; while (cond) { __builtin_amdgcn_s_sleep(1); \
    if ((++_sp & 255u) == 0u) { if (xb_ld(&(bar)[XB_TMO])) break; if (_sp > XB_SPIN_CAP) { atomicAdd(&(bar)[XB_TMO], 1u); break; } } } } while (0)

struct XcdBarrier {
    unsigned* bar; unsigned x;
    volatile LAS unsigned* st;
};

__device__ __forceinline__ XcdBarrier xcd_barrier_post(unsigned* bar, volatile LAS unsigned* st) {
    XcdBarrier b; b.bar = bar; b.x = xb_xcc_id(); b.st = st;
    if (threadIdx.x == 0) (void)xb_add(&bar[XB_XCNT(b.x)], 1u);
    return b;
}
__device__ __forceinline__ void xcd_barrier_complete(unsigned* bar, unsigned x, unsigned& nloc, unsigned& nx) {
    const unsigned G = gridDim.x * gridDim.y * gridDim.z;
    unsigned sum, cnt, mine, sp = 0u;
    for (;;) {
        sum = 0u; cnt = 0u; mine = 0u;
#pragma unroll
        for (unsigned j = 0; j < 16; ++j) { const unsigned c = xb_ld(&bar[XB_XCNT(j)]); sum += c; cnt += (c > 0u) ? 1u : 0u; mine = (j == x) ? c : mine; }
        if (sum == G) break;
        __builtin_amdgcn_s_sleep(1);
        if ((++sp & 255u) == 0u) { if (xb_ld(&bar[XB_TMO])) break; if (sp > XB_SPIN_CAP) { atomicAdd(&bar[XB_TMO], 1u); break; } }
    }
    nloc = mine > 0u ? mine : 1u; nx = cnt > 0u ? cnt : 1u;
}

__device__ __forceinline__ void xcd_barrier(const XcdBarrier& b) {
    asm volatile("s_waitcnt vmcnt(0)" ::: "memory");
    __syncthreads();
    if (threadIdx.x == 0) {
        unsigned* bar = b.bar; const unsigned bx = xb_xcc_id();
        __builtin_amdgcn_s_waitcnt(0);
        unsigned nloc = b.st[0], nx = b.st[1];
        if (nloc == 0u) { xcd_barrier_complete(bar, bx, nloc, nx); b.st[0] = nloc; b.st[1] = nx; }
        const unsigned old = xb_add(&bar[XB_XSUB(bx)], 1u);
        const unsigned gen = old / nloc;
        if (old + 1u == (gen + 1u) * nloc) {
            __builtin_amdgcn_fence(__ATOMIC_RELEASE, "agent");
            asm volatile("s_waitcnt vmcnt(0)" ::: "memory");
            const unsigned og = xb_add(&bar[XB_TOP], 1u);
            const unsigned tg = og / nx;
            if (og + 1u == (tg + 1u) * nx) xb_add(&bar[XB_TOPGEN], 1u);
            else XB_SPIN(xb_ld(&bar[XB_TOPGEN]) == tg, bar);
            __builtin_amdgcn_fence(__ATOMIC_ACQUIRE, "agent");
            xb_add(&bar[XB_XGEN(bx)], 1u);
            asm volatile("s_waitcnt vmcnt(0)" ::: "memory");
        } else {
            XB_SPIN(xb_ld(&bar[XB_XGEN(bx)]) == gen, bar);
            __builtin_amdgcn_fence(__ATOMIC_ACQUIRE, "agent");
            asm volatile("s_waitcnt vmcnt(0)" ::: "memory");
        }
    }
    __syncthreads();
}


__global__ void __launch_bounds__(512, 2) mega(Params p) {
  cg::grid_group grid = cg::this_grid();
  extern __shared__ __attribute__((aligned(16))) unsigned char lds[];
  unsigned char* ws = ows(p.ws);
  const int half = ohalf();
  const int G = gridDim.x, bid = blockIdx.x, G2 = 2 * G, bid2 = 2 * bid + half;
  unsigned char* ldsh = lds + half * LDS_BYTES;
  volatile LAS unsigned* xst = (volatile LAS unsigned*)(lds + 2 * LDS_BYTES);
  if (threadIdx.x == 0) { xst[0] = 0u; xst[1] = 0u; }
  __syncthreads();
  XcdBarrier xb = xcd_barrier_post((unsigned*)(ws + OFF_BAR), xst);
  prologue(p, lds);
  if (p.ws == nullptr) grid.sync();
  xcd_barrier(xb);
  for (int l = 0; l < NLAYER; ++l)
    for (int b = 0; b < NBATCH; ++b) {
      phase1(p, l, b, lds);
      xcd_barrier(xb);
      for (int it = bid2; it < 768 + 1024 + 512 + 512; it += G2) {
        if (it < 768) uq_tile(p, l, b, it, ldsh);
        else if (it < 1792) ukv_tile(p, l, it - 768, ldsh);
        else if (it < 2304) mlstm_local(p, l, (it - 1792) >> 6, (it - 1792) & 63, ldsh);
        else conv_item(p, l, it - 2304);
      }
      xcd_barrier(xb);
      for (int it = G2 - 1 - bid2; it < 256; it += G2) mlstm_scan(p, it);
      for (int it = bid; it < 512; it += G) {
        const int h = it & 7, qb = it < 256 ? 63 - (it >> 3) : (it - 256) >> 3;
        attn_item(p, h, qb, lds);
      }
      xcd_barrier(xb);
      for (int it = bid2; it < 512; it += G2) mlstm_out(p, l, it >> 6, it & 63, ldsh);
      xcd_barrier(xb);
      phase4(p, l, lds);
      xcd_barrier(xb);
      {
        const float* resid = l == 0 ? p.x + (size_t)b * TR * 1024 : p.out + (size_t)b * TR * 1024;
        gemm_resid((const bf16_t*)(ws + OFF_MRG), 1024, (const bf16_t*)(ws + OFF_WOUT + l * SZ_WOUT), resid, p.out + (size_t)b * TR * 1024,
                   (bf16_t*)(ws + OFF_XB1), (float*)(ws + OFF_SS1), lds);
      }
      xcd_barrier(xb);
      phase7(p, l, lds);
      xcd_barrier(xb);
      gemm_resid((const bf16_t*)(ws + OFF_H), 4096, (const bf16_t*)(ws + OFF_WDN + l * SZ_WDN), p.out + (size_t)b * TR * 1024, p.out + (size_t)b * TR * 1024,
                 l == 0 ? (bf16_t*)(ws + OFF_XB) + (size_t)b * TR * 1024 : nullptr, (float*)(ws + OFF_SSX) + (size_t)b * TR * 16, lds);
      xcd_barrier(xb);
    }
}

extern "C" void kernel_launch(void* const* d_in, const int* in_sizes, int n_in, void* d_out, int out_size, void* d_ws, size_t ws_size, hipStream_t stream) {
  static int grid_blocks = 0;
  if (!grid_blocks) {
    int dev = 0, cus = 0, per_cu = 0;
    (void)hipGetDevice(&dev);
    (void)hipDeviceGetAttribute(&cus, hipDeviceAttributeMultiprocessorCount, dev);
    (void)hipFuncSetAttribute((const void*)mega, hipFuncAttributeMaxDynamicSharedMemorySize, (int)LDS_TOTAL);
    (void)hipOccupancyMaxActiveBlocksPerMultiprocessor(&per_cu, mega, 512, LDS_TOTAL);
    if (per_cu > 1) per_cu = 1;
    grid_blocks = cus * per_cu;
  }
  Params p{};
  p.x = (const float*)d_in[0]; p.pos = (const int*)d_in[1]; p.mix_norm = (const float*)d_in[2]; p.w_in = (const float*)d_in[3];
  p.conv_w = (const float*)d_in[4]; p.b_i = (const float*)d_in[5]; p.b_f = (const float*)d_in[6]; p.head_norm = (const float*)d_in[7];
  p.q_a_norm = (const float*)d_in[8]; p.w_uq = (const float*)d_in[9]; p.kv_a_norm = (const float*)d_in[10]; p.w_ukv = (const float*)d_in[11];
  p.q_norm = (const float*)d_in[12]; p.k_norm = (const float*)d_in[13]; p.w_branch = (const float*)d_in[14]; p.w_out = (const float*)d_in[15];
  p.mlp_norm = (const float*)d_in[16]; p.w_up = (const float*)d_in[17]; p.w_down = (const float*)d_in[18];
  p.out = (float*)d_out; p.ws = (unsigned char*)d_ws;
  (void)hipMemsetAsync((unsigned char*)d_ws + OFF_BAR, 0, XCD_BAR_WORDS * 4, stream);
  void* args[] = {&p};
  hipError_t e = hipLaunchCooperativeKernel((void*)mega, dim3(grid_blocks), dim3(512), args, LDS_TOTAL, stream);
  if (e != hipSuccess) fprintf(stderr, "cooperative launch failed: %s (grid %d)\n", hipGetErrorString(e), grid_blocks);
}
```

```cpp
#include <hip/hip_runtime.h>
#include <hip/hip_cooperative_groups.h>
#include <cstdio>
#include <cstdint>
namespace cg = cooperative_groups;

typedef unsigned short bf16_t;
typedef short bf16x8 __attribute__((ext_vector_type(8)));
typedef float f32x4 __attribute__((ext_vector_type(4)));

constexpr int TR = 8192;
constexpr int NBATCH = 4, NLAYER = 2;
constexpr int NIN = 9728;
constexpr int NIN_O = 9680;
constexpr float EPS = 1e-6f;
constexpr size_t LDS_BYTES = 73728;
constexpr size_t LDS_TOTAL = 2 * LDS_BYTES + 256;

constexpr size_t al256(size_t x) { return (x + 255) & ~(size_t)255; }
constexpr size_t SZ_WIN = (size_t)NIN * 1024 * 2, SZ_WUQ = 1536 * 256 * 2, SZ_WUKV = 2048 * 128 * 2, SZ_WBR = (size_t)3 * 1024 * 1024 * 2,
                 SZ_WOUT = 1024 * 1024 * 2, SZ_WUP = (size_t)4096 * 1024 * 2, SZ_WDN = (size_t)4096 * 1024 * 2;
constexpr size_t OFF_WIN = 0;
constexpr size_t OFF_WUQ = OFF_WIN + 2 * SZ_WIN;
constexpr size_t OFF_WUKV = OFF_WUQ + 2 * SZ_WUQ;
constexpr size_t OFF_WBR = OFF_WUKV + 2 * SZ_WUKV;
constexpr size_t OFF_WOUT = OFF_WBR + 2 * SZ_WBR;
constexpr size_t OFF_WUP = OFF_WOUT + 2 * SZ_WOUT;
constexpr size_t OFF_WDN = OFF_WUP + 2 * SZ_WUP;
constexpr size_t OFF_XB = OFF_WDN + 2 * SZ_WDN;
constexpr size_t OFF_SSX = OFF_XB + (size_t)32768 * 1024 * 2;
constexpr size_t OFF_COS = OFF_SSX + (size_t)32768 * 16 * 4;
constexpr size_t OFF_SIN = OFF_COS + (size_t)32768 * 32 * 4;
constexpr size_t OFF_CONV = OFF_SIN + (size_t)32768 * 32 * 4;
constexpr size_t OFF_GATES = OFF_CONV + (size_t)TR * 3072 * 2;
constexpr size_t OFF_H = OFF_CONV;
constexpr size_t OFF_MQ = OFF_GATES + (size_t)TR * 3072 * 2;
constexpr size_t OFF_MK = OFF_MQ + (size_t)TR * 512 * 2;
constexpr size_t OFF_MVT = OFF_MK + (size_t)TR * 512 * 2;
constexpr size_t OFF_MO = OFF_MVT + (size_t)TR * 1024 * 2;
constexpr size_t OFF_MIF = OFF_MO + (size_t)TR * 1024 * 2;
constexpr size_t OFF_CQ = OFF_MIF + (size_t)TR * 16 * 4;
constexpr size_t OFF_CKV = OFF_CQ + (size_t)TR * 256 * 2;
constexpr size_t OFF_SSCQ = OFF_CKV + (size_t)TR * 128 * 2;
constexpr size_t OFF_SSCKV = OFF_SSCQ + (size_t)TR * 4 * 4;
constexpr size_t OFF_K = OFF_SSCKV + (size_t)TR * 2 * 4;
constexpr size_t OFF_Q = OFF_K + (size_t)TR * 1536 * 2;
constexpr size_t OFF_VT = OFF_Q + (size_t)TR * 1536 * 2;
constexpr size_t OFF_YA = OFF_VT + (size_t)TR * 1024 * 2;
constexpr size_t OFF_XB1 = OFF_YA;
constexpr size_t OFF_YB = OFF_YA + (size_t)TR * 1024 * 2;
constexpr size_t OFF_YC = OFF_YB + (size_t)TR * 1024 * 2;
constexpr size_t OFF_MRG = OFF_YC + (size_t)TR * 1024 * 2;
constexpr size_t OFF_SS1 = OFF_MRG + (size_t)TR * 1024 * 2;
constexpr size_t OFF_CLOC = OFF_SS1 + (size_t)TR * 16 * 4;
constexpr size_t OFF_NLOC = OFF_CLOC + (size_t)512 * 8192 * 4;
constexpr size_t OFF_BL = OFF_NLOC + (size_t)512 * 64 * 4;
constexpr size_t OFF_CMX = OFF_BL + 512 * 4;
constexpr size_t OFF_CPREV = OFF_CMX + 512 * 4;
constexpr size_t OFF_NPREV = OFF_CPREV + (size_t)512 * 8192 * 2;
constexpr size_t OFF_MPREV = OFF_NPREV + (size_t)512 * 64 * 4;
constexpr size_t OFF_END = OFF_MPREV + 512 * 4;
constexpr size_t OFF_BAR = al256(OFF_END);
static_assert(OFF_BAR + 16384 <= (size_t)512 * 1024 * 1024, "workspace overflow");

struct Params {
  const float* x; const int* pos; const float* mix_norm; const float* w_in; const float* conv_w; const float* b_i; const float* b_f;
  const float* head_norm; const float* q_a_norm; const float* w_uq; const float* kv_a_norm; const float* w_ukv; const float* q_norm;
  const float* k_norm; const float* w_branch; const float* w_out; const float* mlp_norm; const float* w_up; const float* w_down;
  float* out; unsigned char* ws;
};

__device__ __forceinline__ unsigned pk2(float lo, float hi) { unsigned r; asm("v_cvt_pk_bf16_f32 %0, %1, %2" : "=v"(r) : "v"(lo), "v"(hi)); return r; }
__device__ __forceinline__ bf16_t f2bf(float f) { return (bf16_t)(pk2(f, 0.f) & 0xffffu); }
__device__ __forceinline__ float bf2f(bf16_t h) { return __uint_as_float(((unsigned)h) << 16); }
__device__ __forceinline__ float bflo(unsigned u) { return __uint_as_float(u << 16); }
__device__ __forceinline__ float bfhi(unsigned u) { return __uint_as_float(u & 0xffff0000u); }
__device__ __forceinline__ void st4bf(bf16_t* ptr, float a, float b, float c, float d) { uint2 v; v.x = pk2(a, b); v.y = pk2(c, d); *(uint2*)ptr = v; }
__device__ __forceinline__ float red4(float v) { v += __shfl_xor(v, 16); v += __shfl_xor(v, 32); return v; }
__device__ __forceinline__ float sigmoidf_(float x) { return 1.f / (1.f + __expf(-x)); }
__device__ __forceinline__ int swz8(int row, int ch) { return row * 128 + ((ch ^ ((row >> 1) & 7)) << 4); }
__device__ __forceinline__ int swz16(int row, int ch) { return row * 256 + ((ch ^ (row & 15)) << 4); }
__device__ __forceinline__ int otid() { int t = threadIdx.x & 255; asm volatile("" : "+v"(t)); return t; }
__device__ __forceinline__ unsigned char* ows(unsigned char* w) { unsigned z = 0; asm volatile("" : "+s"(z)); return w + z; }
__device__ __forceinline__ int otid512() { int t = threadIdx.x; asm volatile("" : "+v"(t)); return t; }
__device__ __forceinline__ int ohalf() { return __builtin_amdgcn_readfirstlane((int)(threadIdx.x >> 8)); }
__device__ __forceinline__ void st_pair(bf16_t* p, const f32x4 a, const f32x4 b, int lg) {
  const unsigned a0 = pk2(a[0], a[1]), a1 = pk2(a[2], a[3]), b0 = pk2(b[0], b[1]), b1 = pk2(b[2], b[3]);
  const bool odd = lg & 1;
  const unsigned s0 = odd ? a0 : b0, s1 = odd ? a1 : b1, k0 = odd ? b0 : a0, k1 = odd ? b1 : a1;
  const unsigned r0 = (unsigned)__shfl_xor((int)s0, 16), r1 = (unsigned)__shfl_xor((int)s1, 16);
  uint4 o;
  o.x = odd ? r0 : k0; o.y = odd ? r1 : k1; o.z = odd ? k0 : r0; o.w = odd ? k1 : r1;
  *(uint4*)(p + (odd ? 16 + (lg - 1) * 4 : lg * 4)) = o;
}
#define MFMA(a, b, c) __builtin_amdgcn_mfma_f32_16x16x32_bf16((a), (b), (c), 0, 0, 0)

template <int WM, int WN>
__device__ __forceinline__ void gemm_core(const bf16_t* __restrict__ A, int lda, const bf16_t* __restrict__ B, int ldb, int K,
                                          unsigned char* lds, f32x4 (&acc)[8 / WM][8 / WN]) {
  constexpr int MT = 8 / WM, NT = 8 / WN, RM = 128 / WM, RN = 128 / WN;
  const int tid = otid(), lane = tid & 63, wid = tid >> 6, wr = wid / WN, wc = wid % WN, l15 = lane & 15, lg = lane >> 4;
  const int lrow = tid >> 3, lch = tid & 7;
#pragma unroll
  for (int mt = 0; mt < MT; ++mt)
#pragma unroll
    for (int nt = 0; nt < NT; ++nt) acc[mt][nt] = (f32x4){0.f, 0.f, 0.f, 0.f};
  const bf16_t* Ap = A + (size_t)lrow * lda + lch * 8;
  const bf16_t* Bp = B + (size_t)lrow * ldb + lch * 8;
  const size_t sa = (size_t)32 * lda, sb = (size_t)32 * ldb;
  const int so0 = swz8(lrow, lch);
  uint4 pa0, pa1, pa2, pa3, pb0, pb1, pb2, pb3;
  uint4 qa0, qa1, qa2, qa3, qb0, qb1, qb2, qb3;
#define G_LOAD(S, kt_) do { const bf16_t* a2 = Ap + (kt_) * 64; const bf16_t* b2 = Bp + (kt_) * 64; \
    S##a0 = *(const uint4*)(a2); S##a1 = *(const uint4*)(a2 + sa); S##a2 = *(const uint4*)(a2 + 2 * sa); S##a3 = *(const uint4*)(a2 + 3 * sa); \
    S##b0 = *(const uint4*)(b2); S##b1 = *(const uint4*)(b2 + sb); S##b2 = *(const uint4*)(b2 + 2 * sb); S##b3 = *(const uint4*)(b2 + 3 * sb); } while (0)
#define G_STORE(S, buf_) do { unsigned char* d_ = lds + (buf_) * 32768 + so0; \
    *(uint4*)(d_) = S##a0; *(uint4*)(d_ + 4096) = S##a1; *(uint4*)(d_ + 8192) = S##a2; *(uint4*)(d_ + 12288) = S##a3; \
    *(uint4*)(d_ + 16384) = S##b0; *(uint4*)(d_ + 20480) = S##b1; *(uint4*)(d_ + 24576) = S##b2; *(uint4*)(d_ + 28672) = S##b3; } while (0)
#define G_COMPUTE(buf_) do { const unsigned char* cur = lds + (buf_) * 32768; \
    const unsigned char* ab = cur + swz8(wr * RM + l15, lg); const unsigned char* bb = cur + 16384 + swz8(wc * RN + l15, lg); \
    const int kx = swz8(l15, 4 + lg) - swz8(l15, lg); \
    bf16x8 a0[MT], b0[NT], a1[MT], b1[NT]; \
    _Pragma("unroll") for (int mt = 0; mt < MT; ++mt) a0[mt] = *(const bf16x8*)(ab + mt * 2048); \
    _Pragma("unroll") for (int nt = 0; nt < NT; ++nt) b0[nt] = *(const bf16x8*)(bb + nt * 2048); \
    __builtin_amdgcn_sched_barrier(0); \
    _Pragma("unroll") for (int mt = 0; mt < MT; ++mt) a1[mt] = *(const bf16x8*)(ab + kx + mt * 2048); \
    _Pragma("unroll") for (int nt = 0; nt < NT; ++nt) b1[nt] = *(const bf16x8*)(bb + kx + nt * 2048); \
    _Pragma("unroll") for (int mt = 0; mt < MT; ++mt) \
      _Pragma("unroll") for (int nt = 0; nt < NT; ++nt) acc[mt][nt] = MFMA(b0[nt], a0[mt], acc[mt][nt]); \
    __builtin_amdgcn_sched_barrier(0); \
    _Pragma("unroll") for (int mt = 0; mt < MT; ++mt) \
      _Pragma("unroll") for (int nt = 0; nt < NT; ++nt) acc[mt][nt] = MFMA(b1[nt], a1[mt], acc[mt][nt]); \
    } while (0)
  const int nk = K >> 6;
  G_LOAD(p, 0);
  G_LOAD(q, 1);
  G_STORE(p, 0);
  __syncthreads();
  for (int kt = 0; kt < nk; kt += 2) {
    const int k2 = kt + 2 < nk ? kt + 2 : kt;
    G_LOAD(p, k2);
    __builtin_amdgcn_sched_barrier(0);
    G_COMPUTE(0);
    __builtin_amdgcn_sched_barrier(0);
    G_STORE(q, 1);
    __syncthreads();
    G_LOAD(q, k2 + 1);
    __builtin_amdgcn_sched_barrier(0);
    G_COMPUTE(1);
    __builtin_amdgcn_sched_barrier(0);
    G_STORE(p, 0);
    __syncthreads();
  }
#undef G_LOAD
#undef G_STORE
#undef G_COMPUTE
}

#define STG_DECL uint4 st_a0, st_a1, st_a2, st_a3, st_b0, st_b1, st_b2, st_b3
#define STG_ARGS st_a0, st_a1, st_a2, st_a3, st_b0, st_b1, st_b2, st_b3
#define STG_PARAMS uint4& st_a0, uint4& st_a1, uint4& st_a2, uint4& st_a3, uint4& st_b0, uint4& st_b1, uint4& st_b2, uint4& st_b3
__device__ __forceinline__ void g256_issue(STG_PARAMS, const bf16_t* __restrict__ A, int lda, const bf16_t* __restrict__ B, int ldb) {
  const int tid = otid512(), lrow = tid >> 3, lch = tid & 7;
  const bf16_t* a2 = A + (size_t)lrow * lda + lch * 8; const bf16_t* b2 = B + (size_t)lrow * ldb + lch * 8;
  const size_t sa = (size_t)64 * lda, sb = (size_t)64 * ldb;
  st_a0 = *(const uint4*)(a2); st_a1 = *(const uint4*)(a2 + sa); st_a2 = *(const uint4*)(a2 + 2 * sa); st_a3 = *(const uint4*)(a2 + 3 * sa);
  st_b0 = *(const uint4*)(b2); st_b1 = *(const uint4*)(b2 + sb); st_b2 = *(const uint4*)(b2 + 2 * sb); st_b3 = *(const uint4*)(b2 + 3 * sb);
}
__device__ __forceinline__ void gemm256(const bf16_t* __restrict__ A, int lda, const bf16_t* __restrict__ B, int ldb, int K, unsigned char* lds, f32x4 (&acc)[8][4], STG_PARAMS) {
  const int tid = otid512(), lane = tid & 63, wid = tid >> 6, wr = wid >> 2, wc = wid & 3, l15 = lane & 15, lg = lane >> 4;
  const int lrow = tid >> 3, lch = tid & 7;
#pragma unroll
  for (int mt = 0; mt < 8; ++mt)
#pragma unroll
    for (int nt = 0; nt < 4; ++nt) acc[mt][nt] = (f32x4){0.f, 0.f, 0.f, 0.f};
  const bf16_t* Ap = A + (size_t)lrow * lda + lch * 8;
  const bf16_t* Bp = B + (size_t)lrow * ldb + lch * 8;
  const size_t sa = (size_t)64 * lda, sb = (size_t)64 * ldb;
  const int so0 = swz8(lrow, lch);
  uint4 &pa0 = st_a0, &pa1 = st_a1, &pa2 = st_a2, &pa3 = st_a3, &pb0 = st_b0, &pb1 = st_b1, &pb2 = st_b2, &pb3 = st_b3;
#define H_LOAD(kt_) do { const bf16_t* a2 = Ap + (kt_) * 64; const bf16_t* b2 = Bp + (kt_) * 64; \
    pa0 = *(const uint4*)(a2); pa1 = *(const uint4*)(a2 + sa); pa2 = *(const uint4*)(a2 + 2 * sa); pa3 = *(const uint4*)(a2 + 3 * sa); \
    pb0 = *(const uint4*)(b2); pb1 = *(const uint4*)(b2 + sb); pb2 = *(const uint4*)(b2 + 2 * sb); pb3 = *(const uint4*)(b2 + 3 * sb); } while (0)
#define H_STORE(buf_) do { unsigned char* d_ = lds + (buf_) * 65536 + so0; \
    *(uint4*)(d_) = pa0; *(uint4*)(d_ + 8192) = pa1; *(uint4*)(d_ + 16384) = pa2; *(uint4*)(d_ + 24576) = pa3; \
    *(uint4*)(d_ + 32768) = pb0; *(uint4*)(d_ + 40960) = pb1; *(uint4*)(d_ + 49152) = pb2; *(uint4*)(d_ + 57344) = pb3; } while (0)
  const int nk = K >> 6;
  H_STORE(0);
  H_LOAD(1);
  __syncthreads();
  for (int kt = 0; kt < nk; ++kt) {
    const unsigned char* cur = lds + (kt & 1) * 65536;
    unsigned char* nx_ = lds + ((kt + 1) & 1) * 65536 + so0;
    const int k2 = kt + 2 < nk ? kt + 2 : kt;
    const bf16_t* a2 = Ap + k2 * 64; const bf16_t* b2 = Bp + k2 * 64;
#define RS_A(r, i) do { *(uint4*)(nx_ + (i) * 8192) = r; r = *(const uint4*)(a2 + (i) * sa); } while (0)
#define RS_B(r, i) do { *(uint4*)(nx_ + 32768 + (i) * 8192) = r; r = *(const uint4*)(b2 + (i) * sb); } while (0)
    {
      const unsigned char* ab = cur + swz8(wr * 128 + l15, lg);
      const unsigned char* bb = cur + 32768 + swz8(wc * 64 + l15, lg);
      const int kx = (swz8(l15, 4 + lg) - swz8(l15, lg));
      bf16x8 b0[4], b1[4], aA[4], aB[4];
#define LDB(dst, off) _Pragma("unroll") for (int nt = 0; nt < 4; ++nt) dst[nt] = *(const bf16x8*)(bb + (off) + nt * 2048)
#define LDA(dst, off, mh) _Pragma("unroll") for (int m = 0; m < 4; ++m) dst[m] = *(const bf16x8*)(ab + (off) + ((mh) * 4 + m) * 2048)
#define MMA(aX, bX, mh) _Pragma("unroll") for (int m = 0; m < 4; ++m) _Pragma("unroll") for (int nt = 0; nt < 4; ++nt) acc[(mh) * 4 + m][nt] = MFMA(bX[nt], aX[m], acc[(mh) * 4 + m][nt])
      LDB(b0, 0); LDA(aA, 0, 0);
      __builtin_amdgcn_sched_barrier(0);
      LDA(aB, 0, 1);
      RS_A(pa0, 0); RS_A(pa1, 1); RS_A(pa2, 2);
      MMA(aA, b0, 0);
      __builtin_amdgcn_sched_barrier(0);
      LDB(b1, kx); LDA(aA, kx, 0);
      RS_A(pa3, 3); RS_B(pb0, 0); RS_B(pb1, 1);
      MMA(aB, b0, 1);
      __builtin_amdgcn_sched_barrier(0);
      LDA(aB, kx, 1);
      RS_B(pb2, 2); RS_B(pb3, 3);
      MMA(aA, b1, 0);
      __builtin_amdgcn_sched_barrier(0);
      MMA(aB, b1, 1);
#undef LDB
#undef LDA
#undef MMA
    }
#undef RS_A
#undef RS_B
    __builtin_amdgcn_sched_barrier(0);
    __syncthreads();
  }
#undef H_LOAD
#undef H_STORE
}

__device__ __forceinline__ int map_in(int n) {
  if (n < 6144) return n;
  if (n < 6592) return n + 16;
  if (n < 6608) return n - 448;
  if (n < 6656) return -1;
  return n - 48;
}
__device__ __forceinline__ int map_uq(int n) { return n < 1024 ? (n >> 7) * 192 + (n & 127) : ((n - 1024) >> 6) * 192 + 128 + ((n - 1024) & 63); }
__device__ __forceinline__ int map_ukv(int n) { return n < 1024 ? (n >> 7) * 256 + (n & 127) : ((n - 1024) >> 7) * 256 + 128 + ((n - 1024) & 127); }

__device__ __forceinline__ void transpose_tile(const float* __restrict__ W, int NO, int K, bf16_t* __restrict__ out, int N, int MAP, const float* __restrict__ gain,
                               int tile, float* ldsf) {
  const int ntn = N >> 6, n0 = (tile % ntn) << 6, k0 = (tile / ntn) << 6;
  const int tl = threadIdx.x & 255;
  {
    const int r = tl >> 4, c4 = (tl & 15) * 4, n = n0 + c4;
    const int o = MAP == 0 ? n : MAP == 1 ? map_in(n) : MAP == 2 ? map_uq(n) : map_ukv(n);
#pragma unroll
    for (int i = 0; i < 4; ++i) {
      const int k = k0 + r + 16 * i;
      float4 v = o >= 0 ? *(const float4*)(W + (size_t)k * NO + o) : make_float4(0.f, 0.f, 0.f, 0.f);
      if (gain) { const float g = gain[k]; v.x *= g; v.y *= g; v.z *= g; v.w *= g; }
      *(float4*)(ldsf + (r + 16 * i) * 68 + c4) = v;
    }
  }
  __syncthreads();
  {
    const int nn = tl >> 2, kq = tl & 3;
#pragma unroll
    for (int j = 0; j < 2; ++j) {
      const int kk = (kq + 4 * j) * 8;
      uint4 o;
      o.x = pk2(ldsf[(kk + 0) * 68 + nn], ldsf[(kk + 1) * 68 + nn]); o.y = pk2(ldsf[(kk + 2) * 68 + nn], ldsf[(kk + 3) * 68 + nn]);
      o.z = pk2(ldsf[(kk + 4) * 68 + nn], ldsf[(kk + 5) * 68 + nn]); o.w = pk2(ldsf[(kk + 6) * 68 + nn], ldsf[(kk + 7) * 68 + nn]);
      *(uint4*)(out + (size_t)(n0 + nn) * K + k0 + kk) = o;
    }
  }
  __syncthreads();
}

__device__ __forceinline__ void prologue(const Params& p, unsigned char* lds) {
  const int half = ohalf();
  float* ldsf = (float*)(lds + half * LDS_BYTES);
  unsigned char* ws = ows(p.ws);
  const int G = 2 * gridDim.x, bid = 2 * blockIdx.x + half, tid = threadIdx.x & 255;
  constexpr int TL = 2432 + 96 + 64 + 768 + 256 + 1024 + 1024;
  for (int it = bid; it < 2 * TL; it += G) {
    const int l = it / TL; int r = it % TL;
    if (r < 2432) { transpose_tile(p.w_in + (size_t)l * 1024 * NIN_O, NIN_O, 1024, (bf16_t*)(ws + OFF_WIN + l * SZ_WIN), NIN, 1, p.mix_norm + l * 1024, r, ldsf); continue; }
    r -= 2432;
    if (r < 96) { transpose_tile(p.w_uq + (size_t)l * 256 * 1536, 1536, 256, (bf16_t*)(ws + OFF_WUQ + l * SZ_WUQ), 1536, 2, p.q_a_norm + l * 256, r, ldsf); continue; }
    r -= 96;
    if (r < 64) { transpose_tile(p.w_ukv + (size_t)l * 128 * 2048, 2048, 128, (bf16_t*)(ws + OFF_WUKV + l * SZ_WUKV), 2048, 3, p.kv_a_norm + l * 128, r, ldsf); continue; }
    r -= 64;
    if (r < 768) { const int br = r >> 8; transpose_tile(p.w_branch + ((size_t)l * 3 + br) * 1024 * 1024, 1024, 1024, (bf16_t*)(ws + OFF_WBR + l * SZ_WBR) + (size_t)br * 1024 * 1024, 1024, 0, nullptr, r & 255, ldsf); continue; }
    r -= 768;
    if (r < 256) { transpose_tile(p.w_out + (size_t)l * 1024 * 1024, 1024, 1024, (bf16_t*)(ws + OFF_WOUT + l * SZ_WOUT), 1024, 0, nullptr, r, ldsf); continue; }
    r -= 256;
    if (r < 1024) { transpose_tile(p.w_up + (size_t)l * 1024 * 4096, 4096, 1024, (bf16_t*)(ws + OFF_WUP + l * SZ_WUP), 4096, 0, p.mlp_norm + l * 1024, r, ldsf); continue; }
    r -= 1024;
    transpose_tile(p.w_down + (size_t)l * 4096 * 1024, 1024, 4096, (bf16_t*)(ws + OFF_WDN + l * SZ_WDN), 1024, 0, nullptr, r, ldsf);
  }
  {
    bf16_t* XB = (bf16_t*)(ws + OFF_XB); float* SSX = (float*)(ws + OFF_SSX);
    for (int it = bid; it < 16384; it += G) {
      const int t = it * 2 + (tid >> 7), c = (tid & 127) * 8;
      const float4 a = *(const float4*)(p.x + (size_t)t * 1024 + c), b = *(const float4*)(p.x + (size_t)t * 1024 + c + 4);
      uint4 o; o.x = pk2(a.x, a.y); o.y = pk2(a.z, a.w); o.z = pk2(b.x, b.y); o.w = pk2(b.z, b.w);
      *(uint4*)(XB + (size_t)t * 1024 + c) = o;
      float s = a.x * a.x + a.y * a.y + a.z * a.z + a.w * a.w + b.x * b.x + b.y * b.y + b.z * b.z + b.w * b.w;
      s += __shfl_xor(s, 1); s += __shfl_xor(s, 2); s += __shfl_xor(s, 4);
      if ((tid & 7) == 0) SSX[(size_t)t * 16 + (c >> 6)] = s;
    }
  }
  {
    float* COS = (float*)(ws + OFF_COS); float* SIN = (float*)(ws + OFF_SIN);
    for (int it = bid; it < 4096; it += G) {
      const int e = it * 256 + tid, t = e >> 5, i = e & 31;
      const float invf = (float)exp(-(double)i * (9.210340371976184 / 32.0));
      const float ang = (float)p.pos[t] * invf;
      double a = (double)ang;
      const double n = rint(a * 0.15915494309189535);
      double r = a - n * 6.283185307179586477;
      const double r2 = r * r;
      double sn = 1.0 / 1.5511210043330986e25, cs = 1.0 / 6.2044840173323944e23;
      sn = 1.0 / 2.5852016738884978e22 - sn * r2; cs = 1.0 / 1.1240007277776077e21 - cs * r2;
      sn = 1.0 / 5.109094217170944e19 - sn * r2;  cs = 1.0 / 2.43290200817664e18 - cs * r2;
      sn = 1.0 / 1.21645100408832e17 - sn * r2;   cs = 1.0 / 6.402373705728e15 - cs * r2;
      sn = 1.0 / 3.55687428096e14 - sn * r2;      cs = 1.0 / 2.0922789888e13 - cs * r2;
      sn = 1.0 / 1.307674368e12 - sn * r2;        cs = 1.0 / 8.71782912e10 - cs * r2;
      sn = 1.0 / 6227020800.0 - sn * r2;          cs = 1.0 / 479001600.0 - cs * r2;
      sn = 1.0 / 39916800.0 - sn * r2;            cs = 1.0 / 3628800.0 - cs * r2;
      sn = 1.0 / 362880.0 - sn * r2;              cs = 1.0 / 40320.0 - cs * r2;
      sn = 1.0 / 5040.0 - sn * r2;                cs = 1.0 / 720.0 - cs * r2;
      sn = 1.0 / 120.0 - sn * r2;                 cs = 1.0 / 24.0 - cs * r2;
      sn = 1.0 / 6.0 - sn * r2;                   cs = 1.0 / 2.0 - cs * r2;
      sn = 1.0 - sn * r2;                         cs = 1.0 - cs * r2;
      sn *= r;
      COS[e] = (float)cs; SIN[e] = (float)sn;
    }
  }
}

__device__ __forceinline__ void phase1(const Params& p, int l, int b, unsigned char* lds) {
  unsigned char* ws = ows(p.ws);
  const bf16_t* XB = (const bf16_t*)(ws + OFF_XB) + (size_t)b * TR * 1024;
  const float* SSX = (const float*)(ws + OFF_SSX) + (size_t)b * TR * 16;
  const float* COS = (const float*)(ws + OFF_COS) + (size_t)b * TR * 32;
  const float* SIN = (const float*)(ws + OFF_SIN) + (size_t)b * TR * 32;
  const bf16_t* WT = (const bf16_t*)(ws + OFF_WIN + l * SZ_WIN);
  bf16_t* CONV = (bf16_t*)(ws + OFF_CONV); bf16_t* GATES = (bf16_t*)(ws + OFF_GATES);
  bf16_t* MQ = (bf16_t*)(ws + OFF_MQ); bf16_t* MK = (bf16_t*)(ws + OFF_MK); bf16_t* MVT = (bf16_t*)(ws + OFF_MVT); bf16_t* MO = (bf16_t*)(ws + OFF_MO);
  float* MIF = (float*)(ws + OFF_MIF); bf16_t* CQ = (bf16_t*)(ws + OFF_CQ); bf16_t* CKV = (bf16_t*)(ws + OFF_CKV);
  float* SSCQ = (float*)(ws + OFF_SSCQ); float* SSCKV = (float*)(ws + OFF_SSCKV); bf16_t* KB = (bf16_t*)(ws + OFF_K);
  const float* knorm = p.k_norm + l * 192;
  STG_DECL;
  { const int t0 = blockIdx.x < 32 * 38 ? blockIdx.x : 0; g256_issue(STG_ARGS, XB + (size_t)(t0 & 31) * 256 * 1024, 1024, WT + (size_t)(t0 >> 5) * 256 * 1024, 1024); }
  for (int tile = blockIdx.x; tile < 32 * 38; tile += gridDim.x) {
    const int mtile = tile & 31, ntile = tile >> 5;
    f32x4 acc[8][4];
    gemm256(XB + (size_t)mtile * 256 * 1024, 1024, WT + (size_t)ntile * 256 * 1024, 1024, 1024, lds, acc, STG_ARGS);
    const int tix = otid512(), lane = tix & 63, wid = tix >> 6, l15 = lane & 15, lg = lane >> 4;
    const int rbase = mtile * 256 + (wid >> 2) * 128;
    const int colw = __builtin_amdgcn_readfirstlane(ntile * 256 + (wid & 3) * 64);
#pragma unroll
    for (int mt = 0; mt < 8; ++mt) {
      const float4* sp = (const float4*)(SSX + (size_t)(rbase + mt * 16 + l15) * 16);
      const float4 a = sp[0], b2 = sp[1], c = sp[2], d = sp[3];
      const float s = (a.x + a.y + a.z + a.w) + (b2.x + b2.y + b2.z + b2.w) + (c.x + c.y + c.z + c.w) + (d.x + d.y + d.z + d.w);
      const float rs = rsqrtf(s * (1.f / 1024.f) + EPS);
#pragma unroll
      for (int nt = 0; nt < 4; ++nt) acc[mt][nt] *= rs;
    }
    {
      const int nx = tile + (int)gridDim.x < 32 * 38 ? tile + (int)gridDim.x : tile;
      g256_issue(STG_ARGS, XB + (size_t)(nx & 31) * 256 * 1024, 1024, WT + (size_t)(nx >> 5) * 256 * 1024, 1024);
    }
    if (colw < 3072 || (colw >= 5120 && colw < 6144) || colw >= 6656) {
      bf16_t* dst; int ld, c0;
      if (colw < 3072) { dst = CONV; ld = 3072; c0 = colw; }
      else if (colw < 6144) { dst = MO; ld = 1024; c0 = colw - 5120; }
      else { dst = GATES; ld = 3072; c0 = colw - 6656; }
      const bool sg = colw >= 6656;
#pragma unroll
      for (int mt = 0; mt < 8; ++mt) {
        if (sg) {
#pragma unroll
          for (int nt = 0; nt < 4; ++nt) { f32x4 v = acc[mt][nt]; v[0] = sigmoidf_(v[0]); v[1] = sigmoidf_(v[1]); v[2] = sigmoidf_(v[2]); v[3] = sigmoidf_(v[3]); acc[mt][nt] = v; }
        }
        bf16_t* rp = dst + (size_t)(rbase + mt * 16 + l15) * ld + c0;
        st_pair(rp, acc[mt][0], acc[mt][1], lg); st_pair(rp + 32, acc[mt][2], acc[mt][3], lg);
      }
    } else if (colw < 4096) {
      bf16_t* dst = colw < 3584 ? MQ : MK; const int c0 = colw < 3584 ? colw - 3072 : colw - 3584; const float sc = colw < 3584 ? 0.125f : 1.f;
#pragma unroll
      for (int mt = 0; mt < 8; ++mt) {
        bf16_t* rp = dst + (size_t)(rbase + mt * 16 + l15) * 512 + c0;
        st_pair(rp, acc[mt][0] * sc, acc[mt][1] * sc, lg); st_pair(rp + 32, acc[mt][2] * sc, acc[mt][3] * sc, lg);
      }
    } else if (colw < 5120) {
      const int c0 = colw - 4096;
#pragma unroll
      for (int mt = 0; mt < 8; ++mt)
#pragma unroll
        for (int nt = 0; nt < 4; ++nt)
#pragma unroll
          for (int jj = 0; jj < 4; ++jj)
            MVT[(size_t)(c0 + nt * 16 + lg * 4 + jj) * TR + rbase + mt * 16 + l15] = f2bf(acc[mt][nt][jj]);
    } else if (colw < 6528) {
      const bool iscq = colw < 6400;
      bf16_t* dst = iscq ? CQ : CKV; const int ld = iscq ? 256 : 128; const int c0 = iscq ? colw - 6144 : colw - 6400;
#pragma unroll
      for (int mt = 0; mt < 8; ++mt) {
        float s = 0.f;
#pragma unroll
        for (int nt = 0; nt < 4; ++nt) {
          const f32x4 v = acc[mt][nt];
          s += v[0] * v[0] + v[1] * v[1] + v[2] * v[2] + v[3] * v[3];
        }
        { bf16_t* rp = dst + (size_t)(rbase + mt * 16 + l15) * ld + c0;
          st_pair(rp, acc[mt][0], acc[mt][1], lg); st_pair(rp + 32, acc[mt][2], acc[mt][3], lg); }
        s = red4(s);
        if (lg == 0) {
          const int row = rbase + mt * 16 + l15;
          if (iscq) SSCQ[row * 4 + (c0 >> 6)] = s; else SSCKV[row * 2 + (c0 >> 6)] = s;
        }
      }
    } else if (colw == 6528) {
#pragma unroll
      for (int mt = 0; mt < 8; ++mt) {
        const int row = rbase + mt * 16 + l15;
        float s = 0.f;
#pragma unroll
        for (int nt = 0; nt < 4; ++nt) { const f32x4 v = acc[mt][nt]; s += v[0] * v[0] + v[1] * v[1] + v[2] * v[2] + v[3] * v[3]; }
        s = red4(s);
        const float rn = rsqrtf(s * (1.f / 64.f) + EPS);
#pragma unroll
        for (int nt = 0; nt < 2; ++nt) {
          const int c = nt * 16 + lg * 4;
          const float4 cs = *(const float4*)(COS + (size_t)row * 32 + c), sn = *(const float4*)(SIN + (size_t)row * 32 + c);
          const float4 g1 = *(const float4*)(knorm + 128 + c), g2 = *(const float4*)(knorm + 160 + c);
          const f32x4 a = acc[mt][nt], b2 = acc[mt][nt + 2];
          const float x10 = a[0] * rn * g1.x, x11 = a[1] * rn * g1.y, x12 = a[2] * rn * g1.z, x13 = a[3] * rn * g1.w;
          const float x20 = b2[0] * rn * g2.x, x21 = b2[1] * rn * g2.y, x22 = b2[2] * rn * g2.z, x23 = b2[3] * rn * g2.w;
          uint2 o1, o2;
          o1.x = pk2(x10 * cs.x - x20 * sn.x, x11 * cs.y - x21 * sn.y); o1.y = pk2(x12 * cs.z - x22 * sn.z, x13 * cs.w - x23 * sn.w);
          o2.x = pk2(x10 * sn.x + x20 * cs.x, x11 * sn.y + x21 * cs.y); o2.y = pk2(x12 * sn.z + x22 * cs.z, x13 * sn.w + x23 * cs.w);
#pragma unroll
          for (int h = 0; h < 8; ++h) {
            *(uint2*)(KB + ((size_t)row * 8 + h) * 192 + 128 + c) = o1;
            *(uint2*)(KB + ((size_t)row * 8 + h) * 192 + 160 + c) = o2;
          }
        }
      }
    } else {
#pragma unroll
      for (int mt = 0; mt < 8; ++mt) *(f32x4*)(MIF + (size_t)(rbase + mt * 16 + l15) * 16 + lg * 4) = acc[mt][0];
    }
  }
}

__device__ __forceinline__ void mlstm_gates(const float* __restrict__ MIF, int t0, int h, float bi, float bf, float* sB, float* sU, float* sCM) {
  const int tid = otid();
  if (tid < 128) {
    const float ip = MIF[(size_t)(t0 + tid) * 16 + h] + bi, fp = MIF[(size_t)(t0 + tid) * 16 + 8 + h] + bf;
    const float li = 15.f * tanhf(ip * (1.f / 15.f));
    const float fc = 15.f * tanhf(fp * (1.f / 15.f));
    const float lf = fminf(fc, 0.f) - log1pf(expf(-fabsf(fc)));
    sU[tid] = li; sB[tid] = lf;
  }
  __syncthreads();
  if (tid < 64) {
    const float f0 = sB[2 * tid], f1 = sB[2 * tid + 1], i0 = sU[2 * tid], i1 = sU[2 * tid + 1];
    float v = f0 + f1;
#pragma unroll
    for (int d = 1; d < 64; d <<= 1) { const float o = __shfl_up(v, d); if (tid >= d) v += o; }
    const float b1 = v, b0 = v - f1;
    const float u0 = i0 - b0, u1 = i1 - b1;
    float m = fmaxf(u0, u1);
#pragma unroll
    for (int d = 1; d < 64; d <<= 1) { const float o = __shfl_up(m, d); if (tid >= d) m = fmaxf(m, o); }
    float mprev = __shfl_up(m, 1); if (tid == 0) mprev = -INFINITY;
    sB[2 * tid] = b0; sB[2 * tid + 1] = b1; sU[2 * tid] = u0; sU[2 * tid + 1] = u1;
    sCM[2 * tid] = fmaxf(mprev, u0); sCM[2 * tid + 1] = m;
  }
  __syncthreads();
}

__device__ __forceinline__ void mlstm_local(const Params& p, int l, int h, int c, unsigned char* lds) {
  unsigned char* ws = ows(p.ws);
  const float* MIF = (const float*)(ws + OFF_MIF); const bf16_t* MK = (const bf16_t*)(ws + OFF_MK); const bf16_t* MVT = (const bf16_t*)(ws + OFF_MVT);
  float* CLOC = (float*)(ws + OFF_CLOC) + (size_t)(h * 64 + c) * 8192; float* NLOC = (float*)(ws + OFF_NLOC) + (h * 64 + c) * 64;
  float* sB = (float*)(lds + 65536); float* sU = sB + 128; float* sCM = sU + 128;
  const int tid = otid(), lane = tid & 63, w = tid >> 6, l15 = lane & 15, lg = lane >> 4, t0 = c * 128;
  mlstm_gates(MIF, t0, h, p.b_i[l * 8 + h], p.b_f[l * 8 + h], sB, sU, sCM);
  const float cml = sCM[127];
#pragma unroll
  for (int i = 0; i < 8; ++i) {
    const int cc = tid + i * 256, dv = cc >> 4, ch = cc & 15;
    *(uint4*)(lds + swz16(dv, ch)) = *(const uint4*)(MVT + (size_t)(h * 128 + dv) * TR + t0 + ch * 8);
  }
#pragma unroll
  for (int i = 0; i < 4; ++i) {
    const int cc = tid + i * 256, s = cc >> 3, kc = cc & 7;
    const uint4 kv = *(const uint4*)(MK + (size_t)(t0 + s) * 512 + h * 64 + kc * 8);
    const float wgt = __expf(sU[s] - cml);
    const unsigned u[4] = {kv.x, kv.y, kv.z, kv.w};
#pragma unroll
    for (int j = 0; j < 4; ++j) {
      const int k0 = kc * 8 + 2 * j;
      *(bf16_t*)(lds + 32768 + swz16(k0, s >> 3) + (s & 7) * 2) = f2bf(bflo(u[j]) * wgt);
      *(bf16_t*)(lds + 32768 + swz16(k0 + 1, s >> 3) + (s & 7) * 2) = f2bf(bfhi(u[j]) * wgt);
    }
  }
  __syncthreads();
  f32x4 acc[2][4];
#pragma unroll
  for (int dt = 0; dt < 2; ++dt)
#pragma unroll
    for (int kt = 0; kt < 4; ++kt) acc[dt][kt] = (f32x4){0.f, 0.f, 0.f, 0.f};
#pragma unroll
  for (int ss = 0; ss < 4; ++ss) {
    bf16x8 vf[2], kf[4];
#pragma unroll
    for (int dt = 0; dt < 2; ++dt) vf[dt] = *(const bf16x8*)(lds + swz16(w * 32 + dt * 16 + l15, ss * 4 + lg));
#pragma unroll
    for (int kt = 0; kt < 4; ++kt) kf[kt] = *(const bf16x8*)(lds + 32768 + swz16(kt * 16 + l15, ss * 4 + lg));
#pragma unroll
    for (int dt = 0; dt < 2; ++dt)
#pragma unroll
      for (int kt = 0; kt < 4; ++kt) acc[dt][kt] = MFMA(vf[dt], kf[kt], acc[dt][kt]);
  }
#pragma unroll
  for (int dt = 0; dt < 2; ++dt)
#pragma unroll
    for (int kt = 0; kt < 4; ++kt)
#pragma unroll
      for (int jj = 0; jj < 4; ++jj) CLOC[(w * 32 + dt * 16 + lg * 4 + jj) * 64 + kt * 16 + l15] = acc[dt][kt][jj];
  if (tid < 64) {
    float s = 0.f;
    for (int ch = 0; ch < 16; ++ch) {
      const uint4 v = *(const uint4*)(lds + 32768 + swz16(tid, ch));
      s += bflo(v.x) + bfhi(v.x) + bflo(v.y) + bfhi(v.y) + bflo(v.z) + bfhi(v.z) + bflo(v.w) + bfhi(v.w);
    }
    NLOC[tid] = s;
  }
  if (tid == 0) { ((float*)(ws + OFF_BL))[h * 64 + c] = sB[127]; ((float*)(ws + OFF_CMX))[h * 64 + c] = cml; }
  __syncthreads();
}

__device__ __forceinline__ void mlstm_scan(const Params& p, int item) {
  unsigned char* ws = ows(p.ws);
  const int h = item >> 5, sl = item & 31, tid = otid(), e = sl * 256 + tid;
  const float* CLOC = (const float*)(ws + OFF_CLOC) + (size_t)h * 64 * 8192; const float* NLOC = (const float*)(ws + OFF_NLOC) + h * 64 * 64;
  const float* BL = (const float*)(ws + OFF_BL) + h * 64; const float* CMX = (const float*)(ws + OFF_CMX) + h * 64;
  bf16_t* CPREV = (bf16_t*)(ws + OFF_CPREV) + (size_t)h * 64 * 8192; float* NPREV = (float*)(ws + OFF_NPREV) + h * 64 * 64; float* MPREV = (float*)(ws + OFF_MPREV) + h * 64;
  float cst = 0.f, nst = 0.f, m = 0.f;
  const bool do_n = (sl == 0 && tid < 64);
  for (int c0 = 0; c0 < 64; c0 += 16) {
    float cl[16], bl[16], cm[16], nl[16];
#pragma unroll
    for (int j = 0; j < 16; ++j) {
      cl[j] = CLOC[(size_t)(c0 + j) * 8192 + e]; bl[j] = BL[c0 + j]; cm[j] = CMX[c0 + j];
      nl[j] = do_n ? NLOC[(c0 + j) * 64 + tid] : 0.f;
    }
#pragma unroll
    for (int j = 0; j < 16; ++j) {
      const int c = c0 + j;
      CPREV[(size_t)c * 8192 + e] = f2bf(cst);
      if (do_n) NPREV[c * 64 + tid] = nst;
      if (sl == 0 && tid == 0) MPREV[c] = m;
      const float ml = bl[j] + cm[j];
      const float mn = fmaxf(bl[j] + m, ml), so = __expf(bl[j] + m - mn), sc = __expf(ml - mn);
      cst = so * cst + sc * cl[j];
      nst = so * nst + sc * nl[j];
      m = mn;
    }
  }
}

__device__ __forceinline__ void mlstm_out(const Params& p, int l, int h, int c, unsigned char* lds) {
  unsigned char* ws = ows(p.ws);
  const float* MIF = (const float*)(ws + OFF_MIF); const bf16_t* MQ = (const bf16_t*)(ws + OFF_MQ); const bf16_t* MK = (const bf16_t*)(ws + OFF_MK);
  const bf16_t* MVT = (const bf16_t*)(ws + OFF_MVT); const bf16_t* MO = (const bf16_t*)(ws + OFF_MO); bf16_t* YB = (bf16_t*)(ws + OFF_YB);
  const bf16_t* CPREV = (const bf16_t*)(ws + OFF_CPREV) + (size_t)(h * 64 + c) * 8192; const float* NPREV = (const float*)(ws + OFF_NPREV) + (h * 64 + c) * 64;
  const float mprev = ((const float*)(ws + OFF_MPREV))[h * 64 + c];
  const float* hn = p.head_norm + l * 1024 + h * 128;
  float* sB = (float*)(lds + 65536); float* sU = sB + 128; float* sCM = sU + 128; float* sN = sCM + 128;
  const int tid = otid(), lane = tid & 63, w = tid >> 6, l15 = lane & 15, lg = lane >> 4, t0 = c * 128;
  mlstm_gates(MIF, t0, h, p.b_i[l * 8 + h], p.b_f[l * 8 + h], sB, sU, sCM);
#pragma unroll
  for (int i = 0; i < 8; ++i) {
    const int cc = tid + i * 256, dv = cc >> 4, ch = cc & 15;
    *(uint4*)(lds + swz16(dv, ch)) = *(const uint4*)(MVT + (size_t)(h * 128 + dv) * TR + t0 + ch * 8);
  }
#pragma unroll
  for (int i = 0; i < 4; ++i) {
    const int cc = tid + i * 256, dv = cc >> 3, ch = cc & 7;
    *(uint4*)(lds + 49152 + swz8(dv, ch)) = *(const uint4*)(CPREV + dv * 64 + ch * 8);
  }
  if (tid < 64) sN[tid] = NPREV[tid];
  __syncthreads();
#pragma unroll
  for (int mt = 0; mt < 2; ++mt) {
    const int tl = w * 32 + mt * 16 + l15;
    const float Mt = fmaxf(mprev, sCM[tl]), inter = __expf(mprev - Mt), bt = sB[tl];
    bf16x8 qf[2];
#pragma unroll
    for (int ks = 0; ks < 2; ++ks) qf[ks] = *(const bf16x8*)(MQ + (size_t)(t0 + tl) * 512 + h * 64 + ks * 32 + lg * 8);
    f32x4 acc[8];
#pragma unroll
    for (int dt = 0; dt < 8; ++dt) acc[dt] = (f32x4){0.f, 0.f, 0.f, 0.f};
#pragma unroll
    for (int ks = 0; ks < 2; ++ks)
#pragma unroll
      for (int dt = 0; dt < 8; ++dt) {
        const bf16x8 cf = *(const bf16x8*)(lds + 49152 + swz8(dt * 16 + l15, ks * 4 + lg));
        acc[dt] = MFMA(cf, qf[ks], acc[dt]);
      }
    float dn = 0.f;
#pragma unroll
    for (int ks = 0; ks < 2; ++ks)
#pragma unroll
      for (int j = 0; j < 8; ++j) dn += bf2f((bf16_t)qf[ks][j]) * sN[ks * 32 + lg * 8 + j];
    dn = red4(dn) * inter;
#pragma unroll
    for (int dt = 0; dt < 8; ++dt) acc[dt] *= inter;
    const int ntmax = 2 * w + mt;
    f32x4 s[8];
    float rsum = 0.f;
#pragma unroll
    for (int nt = 0; nt < 8; ++nt) {
      s[nt] = (f32x4){0.f, 0.f, 0.f, 0.f};
      if (nt <= ntmax) {
#pragma unroll
        for (int ks = 0; ks < 2; ++ks) {
          const bf16x8 kf = *(const bf16x8*)(MK + (size_t)(t0 + nt * 16 + l15) * 512 + h * 64 + ks * 32 + lg * 8);
          s[nt] = MFMA(kf, qf[ks], s[nt]);
        }
#pragma unroll
        for (int jj = 0; jj < 4; ++jj) {
          const int sl = nt * 16 + lg * 4 + jj;
          const float wv = sl <= tl ? __expf(sU[sl] - Mt) : 0.f;
          const float pv = s[nt][jj] * wv;
          s[nt][jj] = pv; rsum += pv;
        }
      }
    }
    const float den = dn + red4(rsum);
#pragma unroll
    for (int kk = 0; kk < 4; ++kk) {
      if (2 * kk <= ntmax) {
        union { bf16x8 v; unsigned u[4]; } pf;
        pf.u[0] = pk2(s[2 * kk][0], s[2 * kk][1]); pf.u[1] = pk2(s[2 * kk][2], s[2 * kk][3]);
        pf.u[2] = pk2(s[2 * kk + 1][0], s[2 * kk + 1][1]); pf.u[3] = pk2(s[2 * kk + 1][2], s[2 * kk + 1][3]);
#pragma unroll
        for (int dt = 0; dt < 8; ++dt) {
          const int row = dt * 16 + l15;
          union { bf16x8 v; uint2 h2[2]; } vf;
          vf.h2[0] = *(const uint2*)(lds + swz16(row, kk * 4 + (lg >> 1)) + (lg & 1) * 8);
          vf.h2[1] = *(const uint2*)(lds + swz16(row, kk * 4 + 2 + (lg >> 1)) + (lg & 1) * 8);
          acc[dt] = MFMA(vf.v, pf.v, acc[dt]);
        }
      }
    }
    const float mt_ = bt + Mt;
    const float inv = 1.f / fmaxf(fabsf(den), __expf(-mt_));
    float ssq = 0.f;
#pragma unroll
    for (int dt = 0; dt < 8; ++dt) { acc[dt] *= inv; ssq += acc[dt][0] * acc[dt][0] + acc[dt][1] * acc[dt][1] + acc[dt][2] * acc[dt][2] + acc[dt][3] * acc[dt][3]; }
    ssq = red4(ssq);
    const float rn = rsqrtf(ssq * (1.f / 128.f) + EPS);
#pragma unroll
    for (int dt = 0; dt < 8; ++dt) {
      const int dv = dt * 16 + lg * 4;
      const float4 g = *(const float4*)(hn + dv);
      const uint2 og = *(const uint2*)(MO + (size_t)(t0 + tl) * 1024 + h * 128 + dv);
      st4bf(YB + (size_t)(t0 + tl) * 1024 + h * 128 + dv, acc[dt][0] * rn * g.x * sigmoidf_(bflo(og.x)), acc[dt][1] * rn * g.y * sigmoidf_(bfhi(og.x)),
            acc[dt][2] * rn * g.z * sigmoidf_(bflo(og.y)), acc[dt][3] * rn * g.w * sigmoidf_(bfhi(og.y)));
    }
  }
  __syncthreads();
}

__device__ __forceinline__ void conv_item(const Params& p, int l, int item) {
  unsigned char* ws = ows(p.ws);
  const bf16_t* CONV = (const bf16_t*)(ws + OFF_CONV); bf16_t* YA = (bf16_t*)(ws + OFF_YA);
  const float* cw = p.conv_w + l * 3 * 1024;
  const int tid = otid();
#pragma unroll 2
  for (int i = 0; i < 8; ++i) {
    const int cc = tid + i * 256, t = item * 16 + (cc >> 7), c = (cc & 127) * 8;
    const uint4 gb = *(const uint4*)(CONV + (size_t)t * 3072 + c);
    float z[3][8];
#pragma unroll
    for (int d = 0; d < 3; ++d) {
      const int tt = t - 2 + d;
      if (tt >= 0) {
        const uint4 a = *(const uint4*)(CONV + (size_t)tt * 3072 + 1024 + c), u = *(const uint4*)(CONV + (size_t)tt * 3072 + 2048 + c);
        z[d][0] = bflo(a.x) * bflo(u.x); z[d][1] = bfhi(a.x) * bfhi(u.x); z[d][2] = bflo(a.y) * bflo(u.y); z[d][3] = bfhi(a.y) * bfhi(u.y);
        z[d][4] = bflo(a.z) * bflo(u.z); z[d][5] = bfhi(a.z) * bfhi(u.z); z[d][6] = bflo(a.w) * bflo(u.w); z[d][7] = bfhi(a.w) * bfhi(u.w);
      } else {
#pragma unroll
        for (int j = 0; j < 8; ++j) z[d][j] = 0.f;
      }
    }
    float y[8];
#pragma unroll
    for (int j = 0; j < 8; ++j) y[j] = cw[c + j] * z[0][j] + cw[1024 + c + j] * z[1][j] + cw[2048 + c + j] * z[2][j];
    uint4 o;
    o.x = pk2(bflo(gb.x) * y[0], bfhi(gb.x) * y[1]); o.y = pk2(bflo(gb.y) * y[2], bfhi(gb.y) * y[3]);
    o.z = pk2(bflo(gb.z) * y[4], bfhi(gb.z) * y[5]); o.w = pk2(bflo(gb.w) * y[6], bfhi(gb.w) * y[7]);
    *(uint4*)(YA + (size_t)t * 1024 + c) = o;
  }
}

constexpr float QSCALE = 0.07216878364870322f * 1.4426950408889634f;

__device__ __forceinline__ void uq_tile(const Params& p, int l, int b, int tile, unsigned char* lds) {
  unsigned char* ws = ows(p.ws);
  const bf16_t* CQ = (const bf16_t*)(ws + OFF_CQ); const bf16_t* WT = (const bf16_t*)(ws + OFF_WUQ + l * SZ_WUQ);
  const float* SSCQ = (const float*)(ws + OFF_SSCQ); bf16_t* Q = (bf16_t*)(ws + OFF_Q);
  const float* COS = (const float*)(ws + OFF_COS) + (size_t)b * TR * 32; const float* SIN = (const float*)(ws + OFF_SIN) + (size_t)b * TR * 32;
  const float* qn = p.q_norm + l * 192;
  const int mtile = tile & 63, ntile = tile >> 6;
  const int tix = otid(), lane = tix & 63, wid = tix >> 6, l15 = lane & 15, lg = lane >> 4;
  f32x4 acc[2][8];
  gemm_core<4, 1>(CQ + (size_t)mtile * 128 * 256, 256, WT + (size_t)ntile * 128 * 256, 256, 256, lds, acc);
#pragma unroll
  for (int mt = 0; mt < 2; ++mt) {
    const int row = mtile * 128 + wid * 32 + mt * 16 + l15;
    const float4 sq = *(const float4*)(SSCQ + (size_t)row * 4);
    const float ra = rsqrtf((sq.x + sq.y + sq.z + sq.w) * (1.f / 256.f) + EPS);
#pragma unroll
    for (int nt = 0; nt < 8; ++nt) acc[mt][nt] *= ra;
    if (ntile < 8) {
      float s = 0.f;
#pragma unroll
      for (int nt = 0; nt < 8; ++nt) { const f32x4 v = acc[mt][nt]; s += v[0] * v[0] + v[1] * v[1] + v[2] * v[2] + v[3] * v[3]; }
      s = red4(s);
      const float rn = rsqrtf(s * (1.f / 128.f) + EPS) * QSCALE;
#pragma unroll
      for (int nt = 0; nt < 8; ++nt) {
        const int c = nt * 16 + lg * 4; const float4 g = *(const float4*)(qn + c); const f32x4 v = acc[mt][nt];
        st4bf(Q + ((size_t)row * 8 + ntile) * 192 + c, v[0] * rn * g.x, v[1] * rn * g.y, v[2] * rn * g.z, v[3] * rn * g.w);
      }
    } else {
#pragma unroll
      for (int hf = 0; hf < 2; ++hf) {
        const int h = (ntile - 8) * 2 + hf;
        float s = 0.f;
#pragma unroll
        for (int nt = 0; nt < 4; ++nt) { const f32x4 v = acc[mt][hf * 4 + nt]; s += v[0] * v[0] + v[1] * v[1] + v[2] * v[2] + v[3] * v[3]; }
        s = red4(s);
        const float rn = rsqrtf(s * (1.f / 64.f) + EPS);
#pragma unroll
        for (int nt = 0; nt < 2; ++nt) {
          const int c = nt * 16 + lg * 4;
          const float4 cs = *(const float4*)(COS + (size_t)row * 32 + c), sn = *(const float4*)(SIN + (size_t)row * 32 + c);
          const float4 g1 = *(const float4*)(qn + 128 + c), g2 = *(const float4*)(qn + 160 + c);
          const f32x4 a = acc[mt][hf * 4 + nt], b2 = acc[mt][hf * 4 + nt + 2];
          const float x10 = a[0] * rn * g1.x, x11 = a[1] * rn * g1.y, x12 = a[2] * rn * g1.z, x13 = a[3] * rn * g1.w;
          const float x20 = b2[0] * rn * g2.x, x21 = b2[1] * rn * g2.y, x22 = b2[2] * rn * g2.z, x23 = b2[3] * rn * g2.w;
          st4bf(Q + ((size_t)row * 8 + h) * 192 + 128 + c, (x10 * cs.x - x20 * sn.x) * QSCALE, (x11 * cs.y - x21 * sn.y) * QSCALE,
                (x12 * cs.z - x22 * sn.z) * QSCALE, (x13 * cs.w - x23 * sn.w) * QSCALE);
          st4bf(Q + ((size_t)row * 8 + h) * 192 + 160 + c, (x10 * sn.x + x20 * cs.x) * QSCALE, (x11 * sn.y + x21 * cs.y) * QSCALE,
                (x12 * sn.z + x22 * cs.z) * QSCALE, (x13 * sn.w + x23 * cs.w) * QSCALE);
        }
      }
    }
  }
}

__device__ __forceinline__ void ukv_tile(const Params& p, int l, int tile, unsigned char* lds) {
  unsigned char* ws = ows(p.ws);
  const bf16_t* CKV = (const bf16_t*)(ws + OFF_CKV); const bf16_t* WT = (const bf16_t*)(ws + OFF_WUKV + l * SZ_WUKV);
  const float* SSCKV = (const float*)(ws + OFF_SSCKV); bf16_t* KB = (bf16_t*)(ws + OFF_K); bf16_t* VT = (bf16_t*)(ws + OFF_VT);
  const float* kn = p.k_norm + l * 192;
  const int mtile = tile & 63, ntile = tile >> 6;
  const int tix = otid(), lane = tix & 63, wid = tix >> 6, l15 = lane & 15, lg = lane >> 4;
  f32x4 acc[2][8];
  gemm_core<4, 1>(CKV + (size_t)mtile * 128 * 128, 128, WT + (size_t)ntile * 128 * 128, 128, 128, lds, acc);
#pragma unroll
  for (int mt = 0; mt < 2; ++mt) {
    const int row = mtile * 128 + wid * 32 + mt * 16 + l15;
    const float ra = rsqrtf((SSCKV[row * 2] + SSCKV[row * 2 + 1]) * (1.f / 128.f) + EPS);
#pragma unroll
    for (int nt = 0; nt < 8; ++nt) acc[mt][nt] *= ra;
    if (ntile < 8) {
      float s = 0.f;
#pragma unroll
      for (int nt = 0; nt < 8; ++nt) { const f32x4 v = acc[mt][nt]; s += v[0] * v[0] + v[1] * v[1] + v[2] * v[2] + v[3] * v[3]; }
      s = red4(s);
      const float rn = rsqrtf(s * (1.f / 128.f) + EPS);
#pragma unroll
      for (int nt = 0; nt < 8; ++nt) {
        const int c = nt * 16 + lg * 4; const float4 g = *(const float4*)(kn + c); const f32x4 v = acc[mt][nt];
        st4bf(KB + ((size_t)row * 8 + ntile) * 192 + c, v[0] * rn * g.x, v[1] * rn * g.y, v[2] * rn * g.z, v[3] * rn * g.w);
      }
    } else {
      const int h = ntile - 8;
#pragma unroll
      for (int nt = 0; nt < 8; ++nt)
#pragma unroll
        for (int jj = 0; jj < 4; ++jj) VT[(size_t)(h * 128 + nt * 16 + lg * 4 + jj) * TR + row] = f2bf(acc[mt][nt][jj]);
    }
  }
}

__device__ __forceinline__ void attn_item(const Params& p, int h, int qb, unsigned char* lds0) {
  unsigned char* ws = ows(p.ws); const int half = ohalf(); unsigned char* lds = lds0 + half * LDS_BYTES;
  const bf16_t* Q = (const bf16_t*)(ws + OFF_Q); const bf16_t* KB = (const bf16_t*)(ws + OFF_K); const bf16_t* VT = (const bf16_t*)(ws + OFF_VT);
  bf16_t* YC = (bf16_t*)(ws + OFF_YC);
  const int tid = otid(), lane = tid & 63, w = __builtin_amdgcn_readfirstlane(tid >> 6), l15 = lane & 15, lg = lane >> 4;
  const int r0 = qb * 128 + 32 * w;
  const int fx = (l15 >> 1) & 7, fxc = (fx & 4) << 4;
  const int kfb = l15 * 384 + ((lg ^ (fx & 3)) << 4);
  const int kfe = kfb + fxc, kfo = kfb - fxc;
  const int vfb_ = 24576 + l15 * 128 + (lg & 1) * 8, vg = lg >> 1;
  const int vfa0 = vfb_ + (((0 | vg) ^ (fx & 3)) << 4) + (0 ^ fxc), vfa1 = vfb_ + (((0 | vg) ^ (fx & 3)) << 4) + (64 ^ fxc);
  const int vfb0 = vfb_ + (((2 | vg) ^ (fx & 3)) << 4) + (0 ^ fxc), vfb1 = vfb_ + (((2 | vg) ^ (fx & 3)) << 4) + (64 ^ fxc);
  bf16x8 qf[2][6];
#pragma unroll
  for (int mt = 0; mt < 2; ++mt)
#pragma unroll
    for (int ks = 0; ks < 6; ++ks) qf[mt][ks] = *(const bf16x8*)(Q + ((size_t)(r0 + mt * 16 + l15) * 8 + h) * 192 + ks * 32 + lg * 8);
  f32x4 o[2][8];
#pragma unroll
  for (int mt = 0; mt < 2; ++mt)
#pragma unroll
    for (int dt = 0; dt < 8; ++dt) o[mt][dt] = (f32x4){0.f, 0.f, 0.f, 0.f};
  float mrun[2] = {-INFINITY, -INFINITY}, lsum[2] = {0.f, 0.f};
  const int nh = qb + 1, kt0 = half, nkt = 2 * nh;
  const int skey = tid >> 2, sq = tid & 3, sx = (skey >> 1) & 7;
  const bf16_t* kp = KB + ((size_t)skey * 8 + h) * 192 + sq * 8;
  const int klb = skey * 384 + ((sq ^ (sx & 3)) << 4), kxc = (sx >> 2) << 6;
  const int vdv = tid >> 3, vch = tid & 7;
  const bf16_t* vp = VT + (size_t)(h * 128 + vdv) * TR + vch * 8;
  const int vlo0 = 24576 + swz8(vdv, vch);
  const bf16_t* kq = kp + (size_t)kt0 * 64 * 1536; const bf16_t* vq = vp + kt0 * 64;
  uint4 sk0 = *(const uint4*)kq, sk1 = *(const uint4*)(kq + 32), sk2 = *(const uint4*)(kq + 64), sk3 = *(const uint4*)(kq + 96), sk4 = *(const uint4*)(kq + 128), sk5 = *(const uint4*)(kq + 160);
  uint4 sv0 = *(const uint4*)vq, sv1 = *(const uint4*)(vq + (size_t)32 * TR), sv2 = *(const uint4*)(vq + (size_t)64 * TR), sv3 = *(const uint4*)(vq + (size_t)96 * TR);
  for (int kt = kt0; kt < nkt; kt += 2) {
    __syncthreads();
    *(uint4*)(lds + klb + (0 ^ kxc)) = sk0; *(uint4*)(lds + klb + (64 ^ kxc)) = sk1; *(uint4*)(lds + klb + (128 ^ kxc)) = sk2;
    *(uint4*)(lds + klb + (192 ^ kxc)) = sk3; *(uint4*)(lds + klb + (256 ^ kxc)) = sk4; *(uint4*)(lds + klb + (320 ^ kxc)) = sk5;
    *(uint4*)(lds + vlo0) = sv0; *(uint4*)(lds + vlo0 + 4096) = sv1; *(uint4*)(lds + vlo0 + 8192) = sv2; *(uint4*)(lds + vlo0 + 12288) = sv3;
    __syncthreads();
    {
      const int kn = kt + 2 < nkt ? kt + 2 : kt;
      const bf16_t* k2 = kp + (size_t)kn * 64 * 1536; const bf16_t* v2 = vp + kn * 64;
      sk0 = *(const uint4*)k2; sk1 = *(const uint4*)(k2 + 32); sk2 = *(const uint4*)(k2 + 64); sk3 = *(const uint4*)(k2 + 96); sk4 = *(const uint4*)(k2 + 128); sk5 = *(const uint4*)(k2 + 160);
      sv0 = *(const uint4*)v2; sv1 = *(const uint4*)(v2 + (size_t)32 * TR); sv2 = *(const uint4*)(v2 + (size_t)64 * TR); sv3 = *(const uint4*)(v2 + (size_t)96 * TR);
    }
    if (kt * 64 <= r0 + 31) {
      f32x4 s[2][4];
#pragma unroll
      for (int mt = 0; mt < 2; ++mt) {
        const float ni = mrun[mt] == -INFINITY ? 0.f : -mrun[mt];
#pragma unroll
        for (int nt = 0; nt < 4; ++nt) s[mt][nt] = (f32x4){ni, ni, ni, ni};
      }
#pragma unroll
      for (int ks = 0; ks < 6; ++ks) {
        bf16x8 kf[4];
#pragma unroll
        for (int nt = 0; nt < 4; ++nt) kf[nt] = *(const bf16x8*)(lds + ((ks & 1) ? kfo : kfe) + nt * 6144 + ks * 64);
#pragma unroll
        for (int mt = 0; mt < 2; ++mt)
#pragma unroll
          for (int nt = 0; nt < 4; ++nt) s[mt][nt] = MFMA(kf[nt], qf[mt][ks], s[mt][nt]);
      }
      if (kt * 64 + 63 > r0) {
#pragma unroll
        for (int mt = 0; mt < 2; ++mt)
#pragma unroll
          for (int nt = 0; nt < 4; ++nt)
#pragma unroll
            for (int jj = 0; jj < 4; ++jj)
              if (kt * 64 + nt * 16 + lg * 4 + jj > r0 + mt * 16 + l15) s[mt][nt][jj] = -INFINITY;
      }
      bf16x8 pf[2][2];
#pragma unroll
      for (int mt = 0; mt < 2; ++mt) {
        float mx = -INFINITY;
#pragma unroll
        for (int nt = 0; nt < 4; ++nt) mx = fmaxf(mx, fmaxf(fmaxf(s[mt][nt][0], s[mt][nt][1]), fmaxf(s[mt][nt][2], s[mt][nt][3])));
        mx = fmaxf(mx, __shfl_xor(mx, 16)); mx = fmaxf(mx, __shfl_xor(mx, 32));
        if (__any(mx > 8.f || mrun[mt] == -INFINITY)) {
          const float d = fmaxf(mx, 0.f);
          const float base = mrun[mt] == -INFINITY ? 0.f : mrun[mt];
          const float alpha = mrun[mt] == -INFINITY ? 0.f : __builtin_amdgcn_exp2f(-d);
          mrun[mt] = base + d;
          lsum[mt] *= alpha;
#pragma unroll
          for (int dt = 0; dt < 8; ++dt) o[mt][dt] *= alpha;
#pragma unroll
          for (int nt = 0; nt < 4; ++nt) s[mt][nt] -= d;
        }
        float rsum = 0.f;
#pragma unroll
        for (int nt = 0; nt < 4; ++nt)
#pragma unroll
          for (int jj = 0; jj < 4; ++jj) { const float pv = __builtin_amdgcn_exp2f(s[mt][nt][jj]); s[mt][nt][jj] = pv; rsum += pv; }
        lsum[mt] += rsum;
#pragma unroll
        for (int kk = 0; kk < 2; ++kk) {
          union { bf16x8 v; unsigned u[4]; } t;
          t.u[0] = pk2(s[mt][2 * kk][0], s[mt][2 * kk][1]); t.u[1] = pk2(s[mt][2 * kk][2], s[mt][2 * kk][3]);
          t.u[2] = pk2(s[mt][2 * kk + 1][0], s[mt][2 * kk + 1][1]); t.u[3] = pk2(s[mt][2 * kk + 1][2], s[mt][2 * kk + 1][3]);
          pf[mt][kk] = t.v;
        }
      }
#pragma unroll
      for (int kk = 0; kk < 2; ++kk)
#pragma unroll
        for (int dt = 0; dt < 8; ++dt) {

          union { bf16x8 v; uint2 h2[2]; } vf;
          vf.h2[0] = *(const uint2*)(lds + (kk ? vfa1 : vfa0) + dt * 2048);
          vf.h2[1] = *(const uint2*)(lds + (kk ? vfb1 : vfb0) + dt * 2048);
#pragma unroll
          for (int mt = 0; mt < 2; ++mt) o[mt][dt] = MFMA(vf.v, pf[mt][kk], o[mt][dt]);
        }
    }
  }
  __syncthreads();
  unsigned char* xr = lds0 + LDS_BYTES;
  if (half == 1) {
#pragma unroll
    for (int mt = 0; mt < 2; ++mt)
#pragma unroll
      for (int dt = 0; dt < 8; ++dt) *(f32x4*)(xr + ((mt * 8 + dt) * 256 + tid) * 16) = o[mt][dt];
    *(f32x4*)(xr + 65536 + tid * 16) = (f32x4){mrun[0], mrun[1], lsum[0], lsum[1]};
  }
  __syncthreads();
  if (half == 0) {
    const f32x4 ml = *(const f32x4*)(xr + 65536 + tid * 16);
#pragma unroll
    for (int mt = 0; mt < 2; ++mt) {
      const float m1 = ml[mt], l1 = ml[2 + mt];
      const float mn = fmaxf(mrun[mt], m1);
      const float a0 = __builtin_amdgcn_exp2f(mrun[mt] - mn), a1 = __builtin_amdgcn_exp2f(m1 - mn);
      const float inv = 1.f / red4(lsum[mt] * a0 + l1 * a1);
      const int row = r0 + mt * 16 + l15;
#pragma unroll
      for (int dt = 0; dt < 8; ++dt) {
        const f32x4 o1 = *(const f32x4*)(xr + ((mt * 8 + dt) * 256 + tid) * 16);
        o[mt][dt] = (o[mt][dt] * a0 + o1 * a1) * inv;
      }
#pragma unroll
      for (int dt = 0; dt < 8; dt += 2) st_pair(YC + (size_t)row * 1024 + h * 128 + dt * 16, o[mt][dt], o[mt][dt + 1], lg);
    }
  }
}

__device__ __forceinline__ void phase4(const Params& p, int l, unsigned char* lds0) {
  unsigned char* ws = ows(p.ws); const int half = ohalf(); unsigned char* lds = lds0 + half * LDS_BYTES;
  const bf16_t* Y = (const bf16_t*)(ws + OFF_YA); const bf16_t* WT = (const bf16_t*)(ws + OFF_WBR + l * SZ_WBR);
  const bf16_t* GATES = (const bf16_t*)(ws + OFF_GATES); bf16_t* MRG = (bf16_t*)(ws + OFF_MRG); float* MRGF = (float*)(ws + OFF_CONV);
  const int tix = otid(), lane = tix & 63, wid = tix >> 6, wr = wid >> 1, wc = wid & 1, l15 = lane & 15, lg = lane >> 4;
  for (int tile = 2 * blockIdx.x + half; tile < 64 * 8; tile += 2 * gridDim.x) {
    const int mtile = tile & 63, ntile = tile >> 6;
#pragma unroll 1
    for (int br = 0; br < 3; ++br) {
      f32x4 acc[4][4];
      gemm_core<2, 2>(Y + (size_t)br * TR * 1024 + (size_t)mtile * 128 * 1024, 1024, WT + (size_t)br * 1024 * 1024 + (size_t)ntile * 128 * 1024, 1024, 1024, lds, acc);
      const int t2 = otid(), ln2 = t2 & 63, w2 = t2 >> 6;
      const int row0 = mtile * 128 + (w2 >> 1) * 64 + (ln2 & 15), col0 = ntile * 128 + (w2 & 1) * 64 + (ln2 >> 4) * 4;
      const bf16_t* gp = GATES + (size_t)row0 * 3072 + br * 1024 + col0;
      float* fp = MRGF + (size_t)row0 * 1024 + col0;
      bf16_t* op = MRG + (size_t)row0 * 1024 + col0;
#pragma unroll
      for (int mt = 0; mt < 4; ++mt) {
#pragma unroll
        for (int nt = 0; nt < 4; ++nt) {
          const uint2 g = *(const uint2*)(gp + mt * 16 * 3072 + nt * 16);
          f32x4 v;
          v[0] = bflo(g.x) * acc[mt][nt][0]; v[1] = bfhi(g.x) * acc[mt][nt][1]; v[2] = bflo(g.y) * acc[mt][nt][2]; v[3] = bfhi(g.y) * acc[mt][nt][3];
          if (br > 0) v += *(const f32x4*)(fp + mt * 16 * 1024 + nt * 16);
          if (br < 2) *(f32x4*)(fp + mt * 16 * 1024 + nt * 16) = v; else st4bf(op + mt * 16 * 1024 + nt * 16, v[0], v[1], v[2], v[3]);
        }
        asm volatile("" ::: "memory");
      }
    }
  }
}

__device__ __forceinline__ void gemm_resid(const bf16_t* A, int K, const bf16_t* WT, const float* resid, float* R, bf16_t* XBo, float* SSo, unsigned char* lds0) {
  const int half = ohalf(); unsigned char* lds = lds0 + half * LDS_BYTES;
  const int tix = otid(), lane = tix & 63, wid = tix >> 6, wr = wid >> 1, wc = wid & 1, l15 = lane & 15, lg = lane >> 4;
  for (int tile = 2 * blockIdx.x + half; tile < 64 * 8; tile += 2 * gridDim.x) {
    const int mtile = tile & 63, ntile = tile >> 6;
    const int rbase = mtile * 128 + wr * 64, cbase = ntile * 128 + wc * 64;
    f32x4 acc[4][4];
    gemm_core<2, 2>(A + (size_t)mtile * 128 * K, K, WT + (size_t)ntile * 128 * K, K, K, lds, acc);
#pragma unroll
    for (int mt = 0; mt < 4; ++mt) {
      const int row = rbase + mt * 16 + l15;
      float s = 0.f;
#pragma unroll
      for (int nt = 0; nt < 4; ++nt) {
        const size_t off = (size_t)row * 1024 + cbase + nt * 16 + lg * 4;
        const f32x4 v = *(const f32x4*)(resid + off) + acc[mt][nt];
        *(f32x4*)(R + off) = v;
        acc[mt][nt] = v;
        if (XBo) s += v[0] * v[0] + v[1] * v[1] + v[2] * v[2] + v[3] * v[3];
      }
      if (XBo) { bf16_t* rp = XBo + (size_t)row * 1024 + cbase; st_pair(rp, acc[mt][0], acc[mt][1], lg); st_pair(rp + 32, acc[mt][2], acc[mt][3], lg); }
      if (XBo) { s = red4(s); if (lg == 0) SSo[(size_t)row * 16 + ntile * 2 + wc] = s; }
    }
  }
}

__device__ __forceinline__ void phase7(const Params& p, int l, unsigned char* lds) {
  unsigned char* ws = ows(p.ws);
  const bf16_t* XB1 = (const bf16_t*)(ws + OFF_XB1); const bf16_t* WT = (const bf16_t*)(ws + OFF_WUP + l * SZ_WUP);
  const float* SS1 = (const float*)(ws + OFF_SS1); bf16_t* H = (bf16_t*)(ws + OFF_H);
  STG_DECL;
  { const int t0 = blockIdx.x < 32 * 16 ? blockIdx.x : 0; g256_issue(STG_ARGS, XB1 + (size_t)(t0 & 31) * 256 * 1024, 1024, WT + (size_t)(t0 >> 5) * 256 * 1024, 1024); }
  for (int tile = blockIdx.x; tile < 32 * 16; tile += gridDim.x) {
    const int mtile = tile & 31, ntile = tile >> 5;
    f32x4 acc[8][4];
    gemm256(XB1 + (size_t)mtile * 256 * 1024, 1024, WT + (size_t)ntile * 256 * 1024, 1024, 1024, lds, acc, STG_ARGS);
    { const int nx = tile + (int)gridDim.x < 32 * 16 ? tile + (int)gridDim.x : tile;
      g256_issue(STG_ARGS, XB1 + (size_t)(nx & 31) * 256 * 1024, 1024, WT + (size_t)(nx >> 5) * 256 * 1024, 1024); }
    const int tix = otid512(), lane = tix & 63, wid = tix >> 6, l15 = lane & 15, lg = lane >> 4;
    const int rbase = mtile * 256 + (wid >> 2) * 128, cbase = ntile * 256 + (wid & 3) * 64;
#pragma unroll
    for (int mt = 0; mt < 8; ++mt) {
      const int row = rbase + mt * 16 + l15;
      const float4* sp = (const float4*)(SS1 + (size_t)row * 16);
      const float4 a = sp[0], b2 = sp[1], c = sp[2], d = sp[3];
      const float s = (a.x + a.y + a.z + a.w) + (b2.x + b2.y + b2.z + b2.w) + (c.x + c.y + c.z + c.w) + (d.x + d.y + d.z + d.w);
      const float r = rsqrtf(s * (1.f / 1024.f) + EPS);
#pragma unroll
      for (int nt = 0; nt < 4; ++nt) {
        f32x4 v = acc[mt][nt] * r;
#pragma unroll
        for (int jj = 0; jj < 4; ++jj) { const float t = fmaxf(v[jj], 0.f); v[jj] = t * t; }
        acc[mt][nt] = v;
      }
      { bf16_t* rp = H + (size_t)row * 4096 + cbase;
        st_pair(rp, acc[mt][0], acc[mt][1], lg); st_pair(rp + 32, acc[mt][2], acc[mt][3], lg); }
    }
  }
}

#define XB_TMO      128
#define XB_XCNT(j)  (256  + 64 * (j))
#define XB_XSUB(j)  (1280 + 64 * (j))
#define XB_XGEN(j)  (2304 + 64 * (j))
#define XB_TOP      3328
#define XB_TOPGEN   3392
#define XCD_BAR_WORDS 3456
#define XB_SPIN_CAP (1u << 18)
#define LAS __attribute__((address_space(3)))

__device__ __forceinline__ unsigned xb_ld(unsigned* p)              { return __hip_atomic_load(p, __ATOMIC_RELAXED, __HIP_MEMORY_SCOPE_AGENT); }
__device__ __forceinline__ unsigned xb_add(unsigned* p, unsigned v) { return __hip_atomic_fetch_add(p, v, __ATOMIC_RELAXED, __HIP_MEMORY_SCOPE_AGENT); }
__device__ __forceinline__ unsigned xb_xcc_id() { return (unsigned)__builtin_amdgcn_s_getreg((3 << 11) | 20) & 0xFu; }
#define XB_SPIN(cond, bar) do { unsigned _sp = 0; while (cond) { __builtin_amdgcn_s_sleep(1); \
    if ((++_sp & 255u) == 0u) { if (xb_ld(&(bar)[XB_TMO])) break; if (_sp > XB_SPIN_CAP) { atomicAdd(&(bar)[XB_TMO], 1u); break; } } } } while (0)

struct XcdBarrier {
    unsigned* bar; unsigned x;
    volatile LAS unsigned* st;
};

__device__ __forceinline__ XcdBarrier xcd_barrier_post(unsigned* bar, volatile LAS unsigned* st) {
    XcdBarrier b; b.bar = bar; b.x = xb_xcc_id(); b.st = st;
    if (threadIdx.x == 0) (void)xb_add(&bar[XB_XCNT(b.x)], 1u);
    return b;
}
__device__ __forceinline__ void xcd_barrier_complete(unsigned* bar, unsigned x, unsigned& nloc, unsigned& nx) {
    const unsigned G = gridDim.x * gridDim.y * gridDim.z;
    unsigned sum, cnt, mine, sp = 0u;
    for (;;) {
        sum = 0u; cnt = 0u; mine = 0u;
#pragma unroll
        for (unsigned j = 0; j < 16; ++j) { const unsigned c = xb_ld(&bar[XB_XCNT(j)]); sum += c; cnt += (c > 0u) ? 1u : 0u; mine = (j == x) ? c : mine; }
        if (sum == G) break;
        __builtin_amdgcn_s_sleep(1);
        if ((++sp & 255u) == 0u) { if (xb_ld(&bar[XB_TMO])) break; if (sp > XB_SPIN_CAP) { atomicAdd(&bar[XB_TMO], 1u); break; } }
    }
    nloc = mine > 0u ? mine : 1u; nx = cnt > 0u ? cnt : 1u;
}

__device__ __forceinline__ void xcd_barrier(const XcdBarrier& b) {
    asm volatile("s_waitcnt vmcnt(0)" ::: "memory");
    __syncthreads();
    if (threadIdx.x == 0) {
        unsigned* bar = b.bar; const unsigned bx = xb_xcc_id();
        __builtin_amdgcn_s_waitcnt(0);
        unsigned nloc = b.st[0], nx = b.st[1];
        if (nloc == 0u) { xcd_barrier_complete(bar, bx, nloc, nx); b.st[0] = nloc; b.st[1] = nx; }
        const unsigned old = xb_add(&bar[XB_XSUB(bx)], 1u);
        const unsigned gen = old / nloc;
        if (old + 1u == (gen + 1u) * nloc) {
            __builtin_amdgcn_fence(__ATOMIC_RELEASE, "agent");
            asm volatile("s_waitcnt vmcnt(0)" ::: "memory");
            const unsigned og = xb_add(&bar[XB_TOP], 1u);
            const unsigned tg = og / nx;
            if (og + 1u == (tg + 1u) * nx) xb_add(&bar[XB_TOPGEN], 1u);
            else XB_SPIN(xb_ld(&bar[XB_TOPGEN]) == tg, bar);
            __builtin_amdgcn_fence(__ATOMIC_ACQUIRE, "agent");
            xb_add(&bar[XB_XGEN(bx)], 1u);
            asm volatile("s_waitcnt vmcnt(0)" ::: "memory");
        } else {
            XB_SPIN(xb_ld(&bar[XB_XGEN(bx)]) == gen, bar);
            __builtin_amdgcn_fence(__ATOMIC_ACQUIRE, "agent");
            asm volatile("s_waitcnt vmcnt(0)" ::: "memory");
        }
    }
    __syncthreads();
}


__global__ void __launch_bounds__(512, 2) mega(Params p) {
  cg::grid_group grid = cg::this_grid();
  extern __shared__ __attribute__((aligned(16))) unsigned char lds[];
  unsigned char* ws = ows(p.ws);
  const int half = ohalf();
  const int G = gridDim.x, bid = blockIdx.x, G2 = 2 * G, bid2 = 2 * bid + half;
  unsigned char* ldsh = lds + half * LDS_BYTES;
  volatile LAS unsigned* xst = (volatile LAS unsigned*)(lds + 2 * LDS_BYTES);
  if (threadIdx.x == 0) { xst[0] = 0u; xst[1] = 0u; }
  __syncthreads();
  XcdBarrier xb = xcd_barrier_post((unsigned*)(ws + OFF_BAR), xst);
  prologue(p, lds);
  if (p.ws == nullptr) grid.sync();
  xcd_barrier(xb);
  for (int l = 0; l < NLAYER; ++l)
    for (int b = 0; b < NBATCH; ++b) {
      phase1(p, l, b, lds);
      xcd_barrier(xb);
      for (int it = bid2; it < 768 + 1024 + 512 + 512; it += G2) {
        if (it < 768) uq_tile(p, l, b, it, ldsh);
        else if (it < 1792) ukv_tile(p, l, it - 768, ldsh);
        else if (it < 2304) mlstm_local(p, l, (it - 1792) >> 6, (it - 1792) & 63, ldsh);
        else conv_item(p, l, it - 2304);
      }
      xcd_barrier(xb);
      for (int it = G2 - 1 - bid2; it < 256; it += G2) mlstm_scan(p, it);
      for (int it = bid; it < 512; it += G) {
        const int h = it & 7, qb = it < 256 ? 63 - (it >> 3) : (it - 256) >> 3;
        attn_item(p, h, qb, lds);
      }
      xcd_barrier(xb);
      for (int it = bid2; it < 512; it += G2) mlstm_out(p, l, it >> 6, it & 63, ldsh);
      xcd_barrier(xb);
      phase4(p, l, lds);
      xcd_barrier(xb);
      {
        const float* resid = l == 0 ? p.x + (size_t)b * TR * 1024 : p.out + (size_t)b * TR * 1024;
        gemm_resid((const bf16_t*)(ws + OFF_MRG), 1024, (const bf16_t*)(ws + OFF_WOUT + l * SZ_WOUT), resid, p.out + (size_t)b * TR * 1024,
                   (bf16_t*)(ws + OFF_XB1), (float*)(ws + OFF_SS1), lds);
      }
      xcd_barrier(xb);
      phase7(p, l, lds);
      xcd_barrier(xb);
      gemm_resid((const bf16_t*)(ws + OFF_H), 4096, (const bf16_t*)(ws + OFF_WDN + l * SZ_WDN), p.out + (size_t)b * TR * 1024, p.out + (size_t)b * TR * 1024,
                 l == 0 ? (bf16_t*)(ws + OFF_XB) + (size_t)b * TR * 1024 : nullptr, (float*)(ws + OFF_SSX) + (size_t)b * TR * 16, lds);
      xcd_barrier(xb);
    }
}

extern "C" void kernel_launch(void* const* d_in, const int* in_sizes, int n_in, void* d_out, int out_size, void* d_ws, size_t ws_size, hipStream_t stream) {
  static int grid_blocks = 0;
  if (!grid_blocks) {
    int dev = 0, cus = 0, per_cu = 0;
    (void)hipGetDevice(&dev);
    (void)hipDeviceGetAttribute(&cus, hipDeviceAttributeMultiprocessorCount, dev);
    (void)hipFuncSetAttribute((const void*)mega, hipFuncAttributeMaxDynamicSharedMemorySize, (int)LDS_TOTAL);
    (void)hipOccupancyMaxActiveBlocksPerMultiprocessor(&per_cu, mega, 512, LDS_TOTAL);
    if (per_cu > 1) per_cu = 1;
    grid_blocks = cus * per_cu;
  }
  Params p{};
  p.x = (const float*)d_in[0]; p.pos = (const int*)d_in[1]; p.mix_norm = (const float*)d_in[2]; p.w_in = (const float*)d_in[3];
  p.conv_w = (const float*)d_in[4]; p.b_i = (const float*)d_in[5]; p.b_f = (const float*)d_in[6]; p.head_norm = (const float*)d_in[7];
  p.q_a_norm = (const float*)d_in[8]; p.w_uq = (const float*)d_in[9]; p.kv_a_norm = (const float*)d_in[10]; p.w_ukv = (const float*)d_in[11];
  p.q_norm = (const float*)d_in[12]; p.k_norm = (const float*)d_in[13]; p.w_branch = (const float*)d_in[14]; p.w_out = (const float*)d_in[15];
  p.mlp_norm = (const float*)d_in[16]; p.w_up = (const float*)d_in[17]; p.w_down = (const float*)d_in[18];
  p.out = (float*)d_out; p.ws = (unsigned char*)d_ws;
  (void)hipMemsetAsync((unsigned char*)d_ws + OFF_BAR, 0, XCD_BAR_WORDS * 4, stream);
  void* args[] = {&p};
  hipError_t e = hipLaunchCooperativeKernel((void*)mega, dim3(grid_blocks), dim3(512), args, LDS_TOTAL, stream);
  if (e != hipSuccess) fprintf(stderr, "cooperative launch failed: %s (grid %d)\n", hipGetErrorString(e), grid_blocks);
}
```

```cpp
#include <hip/hip_runtime.h>
#include <hip/hip_cooperative_groups.h>
#include <cstdio>
#include <cstdint>
namespace cg = cooperative_groups;

typedef unsigned short bf16_t;
typedef short bf16x8 __attribute__((ext_vector_type(8)));
typedef float f32x4 __attribute__((ext_vector_type(4)));

constexpr int TR = 8192;
constexpr int NBATCH = 4, NLAYER = 2;
constexpr int NIN = 9728;
constexpr int NIN_O = 9680;
constexpr float EPS = 1e-6f;
constexpr size_t LDS_BYTES = 73728;
constexpr size_t LDS_TOTAL = 2 * LDS_BYTES + 256;

constexpr size_t al256(size_t x) { return (x + 255) & ~(size_t)255; }
constexpr size_t SZ_WIN = (size_t)NIN * 1024 * 2, SZ_WUQ = 1536 * 256 * 2, SZ_WUKV = 2048 * 128 * 2, SZ_WBR = (size_t)3 * 1024 * 1024 * 2,
                 SZ_WOUT = 1024 * 1024 * 2, SZ_WUP = (size_t)4096 * 1024 * 2, SZ_WDN = (size_t)4096 * 1024 * 2;
constexpr size_t OFF_WIN = 0;
constexpr size_t OFF_WUQ = OFF_WIN + 2 * SZ_WIN;
constexpr size_t OFF_WUKV = OFF_WUQ + 2 * SZ_WUQ;
constexpr size_t OFF_WBR = OFF_WUKV + 2 * SZ_WUKV;
constexpr size_t OFF_WOUT = OFF_WBR + 2 * SZ_WBR;
constexpr size_t OFF_WUP = OFF_WOUT + 2 * SZ_WOUT;
constexpr size_t OFF_WDN = OFF_WUP + 2 * SZ_WUP;
constexpr size_t OFF_XB = OFF_WDN + 2 * SZ_WDN;
constexpr size_t OFF_SSX = OFF_XB + (size_t)32768 * 1024 * 2;
constexpr size_t OFF_COS = OFF_SSX + (size_t)32768 * 16 * 4;
constexpr size_t OFF_SIN = OFF_COS + (size_t)32768 * 32 * 4;
constexpr size_t OFF_CONV = OFF_SIN + (size_t)32768 * 32 * 4;
constexpr size_t OFF_GATES = OFF_CONV + (size_t)TR * 3072 * 2;
constexpr size_t OFF_H = OFF_CONV;
constexpr size_t OFF_MQ = OFF_GATES + (size_t)TR * 3072 * 2;
constexpr size_t OFF_MK = OFF_MQ + (size_t)TR * 512 * 2;
constexpr size_t OFF_MVT = OFF_MK + (size_t)TR * 512 * 2;
constexpr size_t OFF_MO = OFF_MVT + (size_t)TR * 1024 * 2;
constexpr size_t OFF_MIF = OFF_MO + (size_t)TR * 1024 * 2;
constexpr size_t OFF_CQ = OFF_MIF + (size_t)TR * 16 * 4;
constexpr size_t OFF_CKV = OFF_CQ + (size_t)TR * 256 * 2;
constexpr size_t OFF_SSCQ = OFF_CKV + (size_t)TR * 128 * 2;
constexpr size_t OFF_SSCKV = OFF_SSCQ + (size_t)TR * 4 * 4;
constexpr size_t OFF_K = OFF_SSCKV + (size_t)TR * 2 * 4;
constexpr size_t OFF_Q = OFF_K + (size_t)TR * 1536 * 2;
constexpr size_t OFF_VT = OFF_Q + (size_t)TR * 1536 * 2;
constexpr size_t OFF_YA = OFF_VT + (size_t)TR * 1024 * 2;
constexpr size_t OFF_XB1 = OFF_YA;
constexpr size_t OFF_YB = OFF_YA + (size_t)TR * 1024 * 2;
constexpr size_t OFF_YC = OFF_YB + (size_t)TR * 1024 * 2;
constexpr size_t OFF_MRG = OFF_YC + (size_t)TR * 1024 * 2;
constexpr size_t OFF_SS1 = OFF_MRG + (size_t)TR * 1024 * 2;
constexpr size_t OFF_CLOC = OFF_SS1 + (size_t)TR * 16 * 4;
constexpr size_t OFF_NLOC = OFF_CLOC + (size_t)512 * 8192 * 4;
constexpr size_t OFF_BL = OFF_NLOC + (size_t)512 * 64 * 4;
constexpr size_t OFF_CMX = OFF_BL + 512 * 4;
constexpr size_t OFF_CPREV = OFF_CMX + 512 * 4;
constexpr size_t OFF_NPREV = OFF_CPREV + (size_t)512 * 8192 * 2;
constexpr size_t OFF_MPREV = OFF_NPREV + (size_t)512 * 64 * 4;
constexpr size_t OFF_END = OFF_MPREV + 512 * 4;
constexpr size_t OFF_BAR = al256(OFF_END);
static_assert(OFF_BAR + 16384 <= (size_t)512 * 1024 * 1024, "workspace overflow");

struct Params {
  const float* x; const int* pos; const float* mix_norm; const float* w_in; const float* conv_w; const float* b_i; const float* b_f;
  const float* head_norm; const float* q_a_norm; const float* w_uq; const float* kv_a_norm; const float* w_ukv; const float* q_norm;
  const float* k_norm; const float* w_branch; const float* w_out; const float* mlp_norm; const float* w_up; const float* w_down;
  float* out; unsigned char* ws;
};

__device__ __forceinline__ unsigned pk2(float lo, float hi) { unsigned r; asm("v_cvt_pk_bf16_f32 %0, %1, %2" : "=v"(r) : "v"(lo), "v"(hi)); return r; }
__device__ __forceinline__ bf16_t f2bf(float f) { return (bf16_t)(pk2(f, 0.f) & 0xffffu); }
__device__ __forceinline__ float bf2f(bf16_t h) { return __uint_as_float(((unsigned)h) << 16); }
__device__ __forceinline__ float bflo(unsigned u) { return __uint_as_float(u << 16); }
__device__ __forceinline__ float bfhi(unsigned u) { return __uint_as_float(u & 0xffff0000u); }
__device__ __forceinline__ void st4bf(bf16_t* ptr, float a, float b, float c, float d) { uint2 v; v.x = pk2(a, b); v.y = pk2(c, d); *(uint2*)ptr = v; }
__device__ __forceinline__ float red4(float v) { v += __shfl_xor(v, 16); v += __shfl_xor(v, 32); return v; }
__device__ __forceinline__ float sigmoidf_(float x) { return 1.f / (1.f + __expf(-x)); }
__device__ __forceinline__ int swz8(int row, int ch) { return row * 128 + ((ch ^ ((row >> 1) & 7)) << 4); }
__device__ __forceinline__ int swz16(int row, int ch) { return row * 256 + ((ch ^ (row & 15)) << 4); }
__device__ __forceinline__ int otid() { int t = threadIdx.x & 255; asm volatile("" : "+v"(t)); return t; }
__device__ __forceinline__ unsigned char* ows(unsigned char* w) { unsigned z = 0; asm volatile("" : "+s"(z)); return w + z; }
__device__ __forceinline__ int otid512() { int t = threadIdx.x; asm volatile("" : "+v"(t)); return t; }
__device__ __forceinline__ int ohalf() { return __builtin_amdgcn_readfirstlane((int)(threadIdx.x >> 8)); }
__device__ __forceinline__ void st_pair(bf16_t* p, const f32x4 a, const f32x4 b, int lg) {
  const unsigned a0 = pk2(a[0], a[1]), a1 = pk2(a[2], a[3]), b0 = pk2(b[0], b[1]), b1 = pk2(b[2], b[3]);
  const bool odd = lg & 1;
  const unsigned s0 = odd ? a0 : b0, s1 = odd ? a1 : b1, k0 = odd ? b0 : a0, k1 = odd ? b1 : a1;
  const unsigned r0 = (unsigned)__shfl_xor((int)s0, 16), r1 = (unsigned)__shfl_xor((int)s1, 16);
  uint4 o;
  o.x = odd ? r0 : k0; o.y = odd ? r1 : k1; o.z = odd ? k0 : r0; o.w = odd ? k1 : r1;
  *(uint4*)(p + (odd ? 16 + (lg - 1) * 4 : lg * 4)) = o;
}
#define MFMA(a, b, c) __builtin_amdgcn_mfma_f32_16x16x32_bf16((a), (b), (c), 0, 0, 0)

template <int WM, int WN>
__device__ __forceinline__ void gemm_core(const bf16_t* __restrict__ A, int lda, const bf16_t* __restrict__ B, int ldb, int K,
                                          unsigned char* lds, f32x4 (&acc)[8 / WM][8 / WN]) {
  constexpr int MT = 8 / WM, NT = 8 / WN, RM = 128 / WM, RN = 128 / WN;
  const int tid = otid(), lane = tid & 63, wid = tid >> 6, wr = wid / WN, wc = wid % WN, l15 = lane & 15, lg = lane >> 4;
  const int lrow = tid >> 3, lch = tid & 7;
#pragma unroll
  for (int mt = 0; mt < MT; ++mt)
#pragma unroll
    for (int nt = 0; nt < NT; ++nt) acc[mt][nt] = (f32x4){0.f, 0.f, 0.f, 0.f};
  const bf16_t* Ap = A + (size_t)lrow * lda + lch * 8;
  const bf16_t* Bp = B + (size_t)lrow * ldb + lch * 8;
  const size_t sa = (size_t)32 * lda, sb = (size_t)32 * ldb;
  const int so0 = swz8(lrow, lch);
  uint4 pa0, pa1, pa2, pa3, pb0, pb1, pb2, pb3;
  uint4 qa0, qa1, qa2, qa3, qb0, qb1, qb2, qb3;
#define G_LOAD(S, kt_) do { const bf16_t* a2 = Ap + (kt_) * 64; const bf16_t* b2 = Bp + (kt_) * 64; \
    S##a0 = *(const uint4*)(a2); S##a1 = *(const uint4*)(a2 + sa); S##a2 = *(const uint4*)(a2 + 2 * sa); S##a3 = *(const uint4*)(a2 + 3 * sa); \
    S##b0 = *(const uint4*)(b2); S##b1 = *(const uint4*)(b2 + sb); S##b2 = *(const uint4*)(b2 + 2 * sb); S##b3 = *(const uint4*)(b2 + 3 * sb); } while (0)
#define G_STORE(S, buf_) do { unsigned char* d_ = lds + (buf_) * 32768 + so0; \
    *(uint4*)(d_) = S##a0; *(uint4*)(d_ + 4096) = S##a1; *(uint4*)(d_ + 8192) = S##a2; *(uint4*)(d_ + 12288) = S##a3; \
    *(uint4*)(d_ + 16384) = S##b0; *(uint4*)(d_ + 20480) = S##b1; *(uint4*)(d_ + 24576) = S##b2; *(uint4*)(d_ + 28672) = S##b3; } while (0)
#define G_COMPUTE(buf_, LOADSTMT) do { const unsigned char* cur = lds + (buf_) * 32768; \
    const unsigned char* ab = cur + swz8(wr * RM + l15, lg); const unsigned char* bb = cur + 16384 + swz8(wc * RN + l15, lg); \
    const int kx = swz8(l15, 4 + lg) - swz8(l15, lg); \
    bf16x8 a0[MT], b0[NT], a1[MT], b1[NT]; \
    _Pragma("unroll") for (int mt = 0; mt < MT; ++mt) a0[mt] = *(const bf16x8*)(ab + mt * 2048); \
    _Pragma("unroll") for (int nt = 0; nt < NT; ++nt) b0[nt] = *(const bf16x8*)(bb + nt * 2048); \
    LOADSTMT; \
    __builtin_amdgcn_sched_barrier(0); \
    _Pragma("unroll") for (int mt = 0; mt < MT; ++mt) a1[mt] = *(const bf16x8*)(ab + kx + mt * 2048); \
    _Pragma("unroll") for (int nt = 0; nt < NT; ++nt) b1[nt] = *(const bf16x8*)(bb + kx + nt * 2048); \
    _Pragma("unroll") for (int mt = 0; mt < MT; ++mt) \
      _Pragma("unroll") for (int nt = 0; nt < NT; ++nt) acc[mt][nt] = MFMA(b0[nt], a0[mt], acc[mt][nt]); \
    __builtin_amdgcn_sched_barrier(0); \
    _Pragma("unroll") for (int mt = 0; mt < MT; ++mt) \
      _Pragma("unroll") for (int nt = 0; nt < NT; ++nt) acc[mt][nt] = MFMA(b1[nt], a1[mt], acc[mt][nt]); \
    } while (0)
  const int nk = K >> 6;
  G_LOAD(p, 0);
  G_LOAD(q, 1);
  G_STORE(p, 0);
  __syncthreads();
  for (int kt = 0; kt < nk; kt += 2) {
    const int k2 = kt + 2 < nk ? kt + 2 : kt;
    G_COMPUTE(0, G_LOAD(p, k2));
    __builtin_amdgcn_sched_barrier(0);
    G_STORE(q, 1);
    __syncthreads();
    G_COMPUTE(1, G_LOAD(q, k2 + 1));
    __builtin_amdgcn_sched_barrier(0);
    G_STORE(p, 0);
    __syncthreads();
  }
#undef G_LOAD
#undef G_STORE
#undef G_COMPUTE
}

#define STG_DECL uint4 st_a0, st_a1, st_a2, st_a3, st_b0, st_b1, st_b2, st_b3
#define STG_ARGS st_a0, st_a1, st_a2, st_a3, st_b0, st_b1, st_b2, st_b3
#define STG_PARAMS uint4& st_a0, uint4& st_a1, uint4& st_a2, uint4& st_a3, uint4& st_b0, uint4& st_b1, uint4& st_b2, uint4& st_b3
__device__ __forceinline__ void g256_issue(STG_PARAMS, const bf16_t* __restrict__ A, int lda, const bf16_t* __restrict__ B, int ldb) {
  const int tid = otid512(), lrow = tid >> 3, lch = tid & 7;
  const bf16_t* a2 = A + (size_t)lrow * lda + lch * 8; const bf16_t* b2 = B + (size_t)lrow * ldb + lch * 8;
  const size_t sa = (size_t)64 * lda, sb = (size_t)64 * ldb;
  st_a0 = *(const uint4*)(a2); st_a1 = *(const uint4*)(a2 + sa); st_a2 = *(const uint4*)(a2 + 2 * sa); st_a3 = *(const uint4*)(a2 + 3 * sa);
  st_b0 = *(const uint4*)(b2); st_b1 = *(const uint4*)(b2 + sb); st_b2 = *(const uint4*)(b2 + 2 * sb); st_b3 = *(const uint4*)(b2 + 3 * sb);
}
__device__ __forceinline__ void gemm256(const bf16_t* __restrict__ A, int lda, const bf16_t* __restrict__ B, int ldb, int K, unsigned char* lds, f32x4 (&acc)[8][4], STG_PARAMS) {
  const int tid = otid512(), lane = tid & 63, wid = tid >> 6, wr = wid >> 2, wc = wid & 3, l15 = lane & 15, lg = lane >> 4;
  const int lrow = tid >> 3, lch = tid & 7;
#pragma unroll
  for (int mt = 0; mt < 8; ++mt)
#pragma unroll
    for (int nt = 0; nt < 4; ++nt) acc[mt][nt] = (f32x4){0.f, 0.f, 0.f, 0.f};
  const bf16_t* Ap = A + (size_t)lrow * lda + lch * 8;
  const bf16_t* Bp = B + (size_t)lrow * ldb + lch * 8;
  const size_t sa = (size_t)64 * lda, sb = (size_t)64 * ldb;
  const int so0 = swz8(lrow, lch);
  uint4 &pa0 = st_a0, &pa1 = st_a1, &pa2 = st_a2, &pa3 = st_a3, &pb0 = st_b0, &pb1 = st_b1, &pb2 = st_b2, &pb3 = st_b3;
#define H_LOAD(kt_) do { const bf16_t* a2 = Ap + (kt_) * 64; const bf16_t* b2 = Bp + (kt_) * 64; \
    pa0 = *(const uint4*)(a2); pa1 = *(const uint4*)(a2 + sa); pa2 = *(const uint4*)(a2 + 2 * sa); pa3 = *(const uint4*)(a2 + 3 * sa); \
    pb0 = *(const uint4*)(b2); pb1 = *(const uint4*)(b2 + sb); pb2 = *(const uint4*)(b2 + 2 * sb); pb3 = *(const uint4*)(b2 + 3 * sb); } while (0)
#define H_STORE(buf_) do { unsigned char* d_ = lds + (buf_) * 65536 + so0; \
    *(uint4*)(d_) = pa0; *(uint4*)(d_ + 8192) = pa1; *(uint4*)(d_ + 16384) = pa2; *(uint4*)(d_ + 24576) = pa3; \
    *(uint4*)(d_ + 32768) = pb0; *(uint4*)(d_ + 40960) = pb1; *(uint4*)(d_ + 49152) = pb2; *(uint4*)(d_ + 57344) = pb3; } while (0)
  const int nk = K >> 6;
  H_STORE(0);
  H_LOAD(1);
  __syncthreads();
  for (int kt = 0; kt < nk; ++kt) {
    const unsigned char* cur = lds + (kt & 1) * 65536;
    unsigned char* nx_ = lds + ((kt + 1) & 1) * 65536 + so0;
    const int k2 = kt + 2 < nk ? kt + 2 : kt;
    const bf16_t* a2 = Ap + k2 * 64; const bf16_t* b2 = Bp + k2 * 64;
#define RS_A(r, i) do { *(uint4*)(nx_ + (i) * 8192) = r; r = *(const uint4*)(a2 + (i) * sa); } while (0)
#define RS_B(r, i) do { *(uint4*)(nx_ + 32768 + (i) * 8192) = r; r = *(const uint4*)(b2 + (i) * sb); } while (0)
    {
      const unsigned char* ab = cur + swz8(wr * 128 + l15, lg);
      const unsigned char* bb = cur + 32768 + swz8(wc * 64 + l15, lg);
      const int kx = (swz8(l15, 4 + lg) - swz8(l15, lg));
      bf16x8 b0[4], b1[4], aA[4], aB[4];
#define LDB(dst, off) _Pragma("unroll") for (int nt = 0; nt < 4; ++nt) dst[nt] = *(const bf16x8*)(bb + (off) + nt * 2048)
#define LDA(dst, off, mh) _Pragma("unroll") for (int m = 0; m < 4; ++m) dst[m] = *(const bf16x8*)(ab + (off) + ((mh) * 4 + m) * 2048)
#define MMA(aX, bX, mh) _Pragma("unroll") for (int m = 0; m < 4; ++m) _Pragma("unroll") for (int nt = 0; nt < 4; ++nt) acc[(mh) * 4 + m][nt] = MFMA(bX[nt], aX[m], acc[(mh) * 4 + m][nt])
      LDB(b0, 0); LDA(aA, 0, 0);
      __builtin_amdgcn_sched_barrier(0);
      LDA(aB, 0, 1);
      RS_A(pa0, 0); RS_A(pa1, 1); RS_A(pa2, 2);
      MMA(aA, b0, 0);
      __builtin_amdgcn_sched_barrier(0);
      LDB(b1, kx); LDA(aA, kx, 0);
      RS_A(pa3, 3); RS_B(pb0, 0); RS_B(pb1, 1);
      MMA(aB, b0, 1);
      __builtin_amdgcn_sched_barrier(0);
      LDA(aB, kx, 1);
      RS_B(pb2, 2); RS_B(pb3, 3);
      MMA(aA, b1, 0);
      __builtin_amdgcn_sched_barrier(0);
      MMA(aB, b1, 1);
#undef LDB
#undef LDA
#undef MMA
    }
#undef RS_A
#undef RS_B
    __builtin_amdgcn_sched_barrier(0);
    __syncthreads();
  }
#undef H_LOAD
#undef H_STORE
}

__device__ __forceinline__ int map_in(int n) {
  if (n < 6144) return n;
  if (n < 6592) return n + 16;
  if (n < 6608) return n - 448;
  if (n < 6656) return -1;
  return n - 48;
}
__device__ __forceinline__ int map_uq(int n) { return n < 1024 ? (n >> 7) * 192 + (n & 127) : ((n - 1024) >> 6) * 192 + 128 + ((n - 1024) & 63); }
__device__ __forceinline__ int map_ukv(int n) { return n < 1024 ? (n >> 7) * 256 + (n & 127) : ((n - 1024) >> 7) * 256 + 128 + ((n - 1024) & 127); }

__device__ __forceinline__ void transpose_tile(const float* __restrict__ W, int NO, int K, bf16_t* __restrict__ out, int N, int MAP, const float* __restrict__ gain,
                               int tile, float* ldsf) {
  const int ntn = N >> 6, n0 = (tile % ntn) << 6, k0 = (tile / ntn) << 6;
  const int tl = threadIdx.x & 255;
  {
    const int r = tl >> 4, c4 = (tl & 15) * 4, n = n0 + c4;
    const int o = MAP == 0 ? n : MAP == 1 ? map_in(n) : MAP == 2 ? map_uq(n) : map_ukv(n);
#pragma unroll
    for (int i = 0; i < 4; ++i) {
      const int k = k0 + r + 16 * i;
      float4 v = o >= 0 ? *(const float4*)(W + (size_t)k * NO + o) : make_float4(0.f, 0.f, 0.f, 0.f);
      if (gain) { const float g = gain[k]; v.x *= g; v.y *= g; v.z *= g; v.w *= g; }
      *(float4*)(ldsf + (r + 16 * i) * 68 + c4) = v;
    }
  }
  __syncthreads();
  {
    const int nn = tl >> 2, kq = tl & 3;
#pragma unroll
    for (int j = 0; j < 2; ++j) {
      const int kk = (kq + 4 * j) * 8;
      uint4 o;
      o.x = pk2(ldsf[(kk + 0) * 68 + nn], ldsf[(kk + 1) * 68 + nn]); o.y = pk2(ldsf[(kk + 2) * 68 + nn], ldsf[(kk + 3) * 68 + nn]);
      o.z = pk2(ldsf[(kk + 4) * 68 + nn], ldsf[(kk + 5) * 68 + nn]); o.w = pk2(ldsf[(kk + 6) * 68 + nn], ldsf[(kk + 7) * 68 + nn]);
      *(uint4*)(out + (size_t)(n0 + nn) * K + k0 + kk) = o;
    }
  }
  __syncthreads();
}

__device__ __forceinline__ void prologue(const Params& p, unsigned char* lds) {
  const int half = ohalf();
  float* ldsf = (float*)(lds + half * LDS_BYTES);
  unsigned char* ws = ows(p.ws);
  const int G = 2 * gridDim.x, bid = 2 * blockIdx.x + half, tid = threadIdx.x & 255;
  constexpr int TL = 2432 + 96 + 64 + 768 + 256 + 1024 + 1024;
  for (int it = bid; it < 2 * TL; it += G) {
    const int l = it / TL; int r = it % TL;
    if (r < 2432) { transpose_tile(p.w_in + (size_t)l * 1024 * NIN_O, NIN_O, 1024, (bf16_t*)(ws + OFF_WIN + l * SZ_WIN), NIN, 1, p.mix_norm + l * 1024, r, ldsf); continue; }
    r -= 2432;
    if (r < 96) { transpose_tile(p.w_uq + (size_t)l * 256 * 1536, 1536, 256, (bf16_t*)(ws + OFF_WUQ + l * SZ_WUQ), 1536, 2, p.q_a_norm + l * 256, r, ldsf); continue; }
    r -= 96;
    if (r < 64) { transpose_tile(p.w_ukv + (size_t)l * 128 * 2048, 2048, 128, (bf16_t*)(ws + OFF_WUKV + l * SZ_WUKV), 2048, 3, p.kv_a_norm + l * 128, r, ldsf); continue; }
    r -= 64;
    if (r < 768) { const int br = r >> 8; transpose_tile(p.w_branch + ((size_t)l * 3 + br) * 1024 * 1024, 1024, 1024, (bf16_t*)(ws + OFF_WBR + l * SZ_WBR) + (size_t)br * 1024 * 1024, 1024, 0, nullptr, r & 255, ldsf); continue; }
    r -= 768;
    if (r < 256) { transpose_tile(p.w_out + (size_t)l * 1024 * 1024, 1024, 1024, (bf16_t*)(ws + OFF_WOUT + l * SZ_WOUT), 1024, 0, nullptr, r, ldsf); continue; }
    r -= 256;
    if (r < 1024) { transpose_tile(p.w_up + (size_t)l * 1024 * 4096, 4096, 1024, (bf16_t*)(ws + OFF_WUP + l * SZ_WUP), 4096, 0, p.mlp_norm + l * 1024, r, ldsf); continue; }
    r -= 1024;
    transpose_tile(p.w_down + (size_t)l * 4096 * 1024, 1024, 4096, (bf16_t*)(ws + OFF_WDN + l * SZ_WDN), 1024, 0, nullptr, r, ldsf);
  }
  {
    bf16_t* XB = (bf16_t*)(ws + OFF_XB); float* SSX = (float*)(ws + OFF_SSX);
    for (int it = bid; it < 16384; it += G) {
      const int t = it * 2 + (tid >> 7), c = (tid & 127) * 8;
      const float4 a = *(const float4*)(p.x + (size_t)t * 1024 + c), b = *(const float4*)(p.x + (size_t)t * 1024 + c + 4);
      uint4 o; o.x = pk2(a.x, a.y); o.y = pk2(a.z, a.w); o.z = pk2(b.x, b.y); o.w = pk2(b.z, b.w);
      *(uint4*)(XB + (size_t)t * 1024 + c) = o;
      float s = a.x * a.x + a.y * a.y + a.z * a.z + a.w * a.w + b.x * b.x + b.y * b.y + b.z * b.z + b.w * b.w;
      s += __shfl_xor(s, 1); s += __shfl_xor(s, 2); s += __shfl_xor(s, 4);
      if ((tid & 7) == 0) SSX[(size_t)t * 16 + (c >> 6)] = s;
    }
  }
  {
    float* COS = (float*)(ws + OFF_COS); float* SIN = (float*)(ws + OFF_SIN);
    for (int it = bid; it < 4096; it += G) {
      const int e = it * 256 + tid, t = e >> 5, i = e & 31;
      const float invf = (float)exp(-(double)i * (9.210340371976184 / 32.0));
      const float ang = (float)p.pos[t] * invf;
      double a = (double)ang;
      const double n = rint(a * 0.15915494309189535);
      double r = a - n * 6.283185307179586477;
      const double r2 = r * r;
      double sn = 1.0 / 1.5511210043330986e25, cs = 1.0 / 6.2044840173323944e23;
      sn = 1.0 / 2.5852016738884978e22 - sn * r2; cs = 1.0 / 1.1240007277776077e21 - cs * r2;
      sn = 1.0 / 5.109094217170944e19 - sn * r2;  cs = 1.0 / 2.43290200817664e18 - cs * r2;
      sn = 1.0 / 1.21645100408832e17 - sn * r2;   cs = 1.0 / 6.402373705728e15 - cs * r2;
      sn = 1.0 / 3.55687428096e14 - sn * r2;      cs = 1.0 / 2.0922789888e13 - cs * r2;
      sn = 1.0 / 1.307674368e12 - sn * r2;        cs = 1.0 / 8.71782912e10 - cs * r2;
      sn = 1.0 / 6227020800.0 - sn * r2;          cs = 1.0 / 479001600.0 - cs * r2;
      sn = 1.0 / 39916800.0 - sn * r2;            cs = 1.0 / 3628800.0 - cs * r2;
      sn = 1.0 / 362880.0 - sn * r2;              cs = 1.0 / 40320.0 - cs * r2;
      sn = 1.0 / 5040.0 - sn * r2;                cs = 1.0 / 720.0 - cs * r2;
      sn = 1.0 / 120.0 - sn * r2;                 cs = 1.0 / 24.0 - cs * r2;
      sn = 1.0 / 6.0 - sn * r2;                   cs = 1.0 / 2.0 - cs * r2;
      sn = 1.0 - sn * r2;                         cs = 1.0 - cs * r2;
      sn *= r;
      COS[e] = (float)cs; SIN[e] = (float)sn;
    }
  }
}

__device__ __forceinline__ void phase1(const Params& p, int l, int b, unsigned char* lds) {
  unsigned char* ws = ows(p.ws);
  const bf16_t* XB = (const bf16_t*)(ws + OFF_XB) + (size_t)b * TR * 1024;
  const float* SSX = (const float*)(ws + OFF_SSX) + (size_t)b * TR * 16;
  const float* COS = (const float*)(ws + OFF_COS) + (size_t)b * TR * 32;
  const float* SIN = (const float*)(ws + OFF_SIN) + (size_t)b * TR * 32;
  const bf16_t* WT = (const bf16_t*)(ws + OFF_WIN + l * SZ_WIN);
  bf16_t* CONV = (bf16_t*)(ws + OFF_CONV); bf16_t* GATES = (bf16_t*)(ws + OFF_GATES);
  bf16_t* MQ = (bf16_t*)(ws + OFF_MQ); bf16_t* MK = (bf16_t*)(ws + OFF_MK); bf16_t* MVT = (bf16_t*)(ws + OFF_MVT); bf16_t* MO = (bf16_t*)(ws + OFF_MO);
  float* MIF = (float*)(ws + OFF_MIF); bf16_t* CQ = (bf16_t*)(ws + OFF_CQ); bf16_t* CKV = (bf16_t*)(ws + OFF_CKV);
  float* SSCQ = (float*)(ws + OFF_SSCQ); float* SSCKV = (float*)(ws + OFF_SSCKV); bf16_t* KB = (bf16_t*)(ws + OFF_K);
  const float* knorm = p.k_norm + l * 192;
  STG_DECL;
  { const int t0 = blockIdx.x < 32 * 38 ? blockIdx.x : 0; g256_issue(STG_ARGS, XB + (size_t)(t0 & 31) * 256 * 1024, 1024, WT + (size_t)(t0 >> 5) * 256 * 1024, 1024); }
  for (int tile = blockIdx.x; tile < 32 * 38; tile += gridDim.x) {
    const int mtile = tile & 31, ntile = tile >> 5;
    f32x4 acc[8][4];
    gemm256(XB + (size_t)mtile * 256 * 1024, 1024, WT + (size_t)ntile * 256 * 1024, 1024, 1024, lds, acc, STG_ARGS);
    const int tix = otid512(), lane = tix & 63, wid = tix >> 6, l15 = lane & 15, lg = lane >> 4;
    const int rbase = mtile * 256 + (wid >> 2) * 128;
    const int colw = __builtin_amdgcn_readfirstlane(ntile * 256 + (wid & 3) * 64);
#pragma unroll
    for (int mt = 0; mt < 8; ++mt) {
      const float4* sp = (const float4*)(SSX + (size_t)(rbase + mt * 16 + l15) * 16);
      const float4 a = sp[0], b2 = sp[1], c = sp[2], d = sp[3];
      const float s = (a.x + a.y + a.z + a.w) + (b2.x + b2.y + b2.z + b2.w) + (c.x + c.y + c.z + c.w) + (d.x + d.y + d.z + d.w);
      const float rs = rsqrtf(s * (1.f / 1024.f) + EPS);
#pragma unroll
      for (int nt = 0; nt < 4; ++nt) acc[mt][nt] *= rs;
    }
    {
      const int nx = tile + (int)gridDim.x < 32 * 38 ? tile + (int)gridDim.x : tile;
      g256_issue(STG_ARGS, XB + (size_t)(nx & 31) * 256 * 1024, 1024, WT + (size_t)(nx >> 5) * 256 * 1024, 1024);
    }
    if (colw < 3072 || (colw >= 5120 && colw < 6144) || colw >= 6656) {
      bf16_t* dst; int ld, c0;
      if (colw < 3072) { dst = CONV; ld = 3072; c0 = colw; }
      else if (colw < 6144) { dst = MO; ld = 1024; c0 = colw - 5120; }
      else { dst = GATES; ld = 3072; c0 = colw - 6656; }
      const bool sg = colw >= 6656;
#pragma unroll
      for (int mt = 0; mt < 8; ++mt) {
        if (sg) {
#pragma unroll
          for (int nt = 0; nt < 4; ++nt) { f32x4 v = acc[mt][nt]; v[0] = sigmoidf_(v[0]); v[1] = sigmoidf_(v[1]); v[2] = sigmoidf_(v[2]); v[3] = sigmoidf_(v[3]); acc[mt][nt] = v; }
        }
        bf16_t* rp = dst + (size_t)(rbase + mt * 16 + l15) * ld + c0;
        st_pair(rp, acc[mt][0], acc[mt][1], lg); st_pair(rp + 32, acc[mt][2], acc[mt][3], lg);
      }
    } else if (colw < 4096) {
      bf16_t* dst = colw < 3584 ? MQ : MK; const int c0 = colw < 3584 ? colw - 3072 : colw - 3584; const float sc = colw < 3584 ? 0.125f : 1.f;
#pragma unroll
      for (int mt = 0; mt < 8; ++mt) {
        bf16_t* rp = dst + (size_t)(rbase + mt * 16 + l15) * 512 + c0;
        st_pair(rp, acc[mt][0] * sc, acc[mt][1] * sc, lg); st_pair(rp + 32, acc[mt][2] * sc, acc[mt][3] * sc, lg);
      }
    } else if (colw < 5120) {
      const int c0 = colw - 4096;
#pragma unroll
      for (int mt = 0; mt < 8; ++mt)
#pragma unroll
        for (int nt = 0; nt < 4; ++nt)
#pragma unroll
          for (int jj = 0; jj < 4; ++jj)
            MVT[(size_t)(c0 + nt * 16 + lg * 4 + jj) * TR + rbase + mt * 16 + l15] = f2bf(acc[mt][nt][jj]);
    } else if (colw < 6528) {
      const bool iscq = colw < 6400;
      bf16_t* dst = iscq ? CQ : CKV; const int ld = iscq ? 256 : 128; const int c0 = iscq ? colw - 6144 : colw - 6400;
#pragma unroll
      for (int mt = 0; mt < 8; ++mt) {
        float s = 0.f;
#pragma unroll
        for (int nt = 0; nt < 4; ++nt) {
          const f32x4 v = acc[mt][nt];
          s += v[0] * v[0] + v[1] * v[1] + v[2] * v[2] + v[3] * v[3];
        }
        { bf16_t* rp = dst + (size_t)(rbase + mt * 16 + l15) * ld + c0;
          st_pair(rp, acc[mt][0], acc[mt][1], lg); st_pair(rp + 32, acc[mt][2], acc[mt][3], lg); }
        s = red4(s);
        if (lg == 0) {
          const int row = rbase + mt * 16 + l15;
          if (iscq) SSCQ[row * 4 + (c0 >> 6)] = s; else SSCKV[row * 2 + (c0 >> 6)] = s;
        }
      }
    } else if (colw == 6528) {
#pragma unroll
      for (int mt = 0; mt < 8; ++mt) {
        const int row = rbase + mt * 16 + l15;
        float s = 0.f;
#pragma unroll
        for (int nt = 0; nt < 4; ++nt) { const f32x4 v = acc[mt][nt]; s += v[0] * v[0] + v[1] * v[1] + v[2] * v[2] + v[3] * v[3]; }
        s = red4(s);
        const float rn = rsqrtf(s * (1.f / 64.f) + EPS);
#pragma unroll
        for (int nt = 0; nt < 2; ++nt) {
          const int c = nt * 16 + lg * 4;
          const float4 cs = *(const float4*)(COS + (size_t)row * 32 + c), sn = *(const float4*)(SIN + (size_t)row * 32 + c);
          const float4 g1 = *(const float4*)(knorm + 128 + c), g2 = *(const float4*)(knorm + 160 + c);
          const f32x4 a = acc[mt][nt], b2 = acc[mt][nt + 2];
          const float x10 = a[0] * rn * g1.x, x11 = a[1] * rn * g1.y, x12 = a[2] * rn * g1.z, x13 = a[3] * rn * g1.w;
          const float x20 = b2[0] * rn * g2.x, x21 = b2[1] * rn * g2.y, x22 = b2[2] * rn * g2.z, x23 = b2[3] * rn * g2.w;
          uint2 o1, o2;
          o1.x = pk2(x10 * cs.x - x20 * sn.x, x11 * cs.y - x21 * sn.y); o1.y = pk2(x12 * cs.z - x22 * sn.z, x13 * cs.w - x23 * sn.w);
          o2.x = pk2(x10 * sn.x + x20 * cs.x, x11 * sn.y + x21 * cs.y); o2.y = pk2(x12 * sn.z + x22 * cs.z, x13 * sn.w + x23 * cs.w);
#pragma unroll
          for (int h = 0; h < 8; ++h) {
            *(uint2*)(KB + ((size_t)row * 8 + h) * 192 + 128 + c) = o1;
            *(uint2*)(KB + ((size_t)row * 8 + h) * 192 + 160 + c) = o2;
          }
        }
      }
    } else {
#pragma unroll
      for (int mt = 0; mt < 8; ++mt) *(f32x4*)(MIF + (size_t)(rbase + mt * 16 + l15) * 16 + lg * 4) = acc[mt][0];
    }
  }
}

__device__ __forceinline__ void mlstm_gates(const float* __restrict__ MIF, int t0, int h, float bi, float bf, float* sB, float* sU, float* sCM) {
  const int tid = otid();
  if (tid < 128) {
    const float ip = MIF[(size_t)(t0 + tid) * 16 + h] + bi, fp = MIF[(size_t)(t0 + tid) * 16 + 8 + h] + bf;
    const float li = 15.f * tanhf(ip * (1.f / 15.f));
    const float fc = 15.f * tanhf(fp * (1.f / 15.f));
    const float lf = fminf(fc, 0.f) - log1pf(expf(-fabsf(fc)));
    sU[tid] = li; sB[tid] = lf;
  }
  __syncthreads();
  if (tid < 64) {
    const float f0 = sB[2 * tid], f1 = sB[2 * tid + 1], i0 = sU[2 * tid], i1 = sU[2 * tid + 1];
    float v = f0 + f1;
#pragma unroll
    for (int d = 1; d < 64; d <<= 1) { const float o = __shfl_up(v, d); if (tid >= d) v += o; }
    const float b1 = v, b0 = v - f1;
    const float u0 = i0 - b0, u1 = i1 - b1;
    float m = fmaxf(u0, u1);
#pragma unroll
    for (int d = 1; d < 64; d <<= 1) { const float o = __shfl_up(m, d); if (tid >= d) m = fmaxf(m, o); }
    float mprev = __shfl_up(m, 1); if (tid == 0) mprev = -INFINITY;
    sB[2 * tid] = b0; sB[2 * tid + 1] = b1; sU[2 * tid] = u0; sU[2 * tid + 1] = u1;
    sCM[2 * tid] = fmaxf(mprev, u0); sCM[2 * tid + 1] = m;
  }
  __syncthreads();
}

__device__ __forceinline__ void mlstm_local(const Params& p, int l, int h, int c, unsigned char* lds) {
  unsigned char* ws = ows(p.ws);
  const float* MIF = (const float*)(ws + OFF_MIF); const bf16_t* MK = (const bf16_t*)(ws + OFF_MK); const bf16_t* MVT = (const bf16_t*)(ws + OFF_MVT);
  float* CLOC = (float*)(ws + OFF_CLOC) + (size_t)(h * 64 + c) * 8192; float* NLOC = (float*)(ws + OFF_NLOC) + (h * 64 + c) * 64;
  float* sB = (float*)(lds + 65536); float* sU = sB + 128; float* sCM = sU + 128;
  const int tid = otid(), lane = tid & 63, w = tid >> 6, l15 = lane & 15, lg = lane >> 4, t0 = c * 128;
  mlstm_gates(MIF, t0, h, p.b_i[l * 8 + h], p.b_f[l * 8 + h], sB, sU, sCM);
  const float cml = sCM[127];
#pragma unroll
  for (int i = 0; i < 8; ++i) {
    const int cc = tid + i * 256, dv = cc >> 4, ch = cc & 15;
    *(uint4*)(lds + swz16(dv, ch)) = *(const uint4*)(MVT + (size_t)(h * 128 + dv) * TR + t0 + ch * 8);
  }
#pragma unroll
  for (int i = 0; i < 4; ++i) {
    const int cc = tid + i * 256, s = cc >> 3, kc = cc & 7;
    const uint4 kv = *(const uint4*)(MK + (size_t)(t0 + s) * 512 + h * 64 + kc * 8);
    const float wgt = __expf(sU[s] - cml);
    const unsigned u[4] = {kv.x, kv.y, kv.z, kv.w};
#pragma unroll
    for (int j = 0; j < 4; ++j) {
      const int k0 = kc * 8 + 2 * j;
      *(bf16_t*)(lds + 32768 + swz16(k0, s >> 3) + (s & 7) * 2) = f2bf(bflo(u[j]) * wgt);
      *(bf16_t*)(lds + 32768 + swz16(k0 + 1, s >> 3) + (s & 7) * 2) = f2bf(bfhi(u[j]) * wgt);
    }
  }
  __syncthreads();
  f32x4 acc[2][4];
#pragma unroll
  for (int dt = 0; dt < 2; ++dt)
#pragma unroll
    for (int kt = 0; kt < 4; ++kt) acc[dt][kt] = (f32x4){0.f, 0.f, 0.f, 0.f};
#pragma unroll
  for (int ss = 0; ss < 4; ++ss) {
    bf16x8 vf[2], kf[4];
#pragma unroll
    for (int dt = 0; dt < 2; ++dt) vf[dt] = *(const bf16x8*)(lds + swz16(w * 32 + dt * 16 + l15, ss * 4 + lg));
#pragma unroll
    for (int kt = 0; kt < 4; ++kt) kf[kt] = *(const bf16x8*)(lds + 32768 + swz16(kt * 16 + l15, ss * 4 + lg));
#pragma unroll
    for (int dt = 0; dt < 2; ++dt)
#pragma unroll
      for (int kt = 0; kt < 4; ++kt) acc[dt][kt] = MFMA(vf[dt], kf[kt], acc[dt][kt]);
  }
#pragma unroll
  for (int dt = 0; dt < 2; ++dt)
#pragma unroll
    for (int kt = 0; kt < 4; ++kt)
#pragma unroll
      for (int jj = 0; jj < 4; ++jj) CLOC[(w * 32 + dt * 16 + lg * 4 + jj) * 64 + kt * 16 + l15] = acc[dt][kt][jj];
  if (tid < 64) {
    float s = 0.f;
    for (int ch = 0; ch < 16; ++ch) {
      const uint4 v = *(const uint4*)(lds + 32768 + swz16(tid, ch));
      s += bflo(v.x) + bfhi(v.x) + bflo(v.y) + bfhi(v.y) + bflo(v.z) + bfhi(v.z) + bflo(v.w) + bfhi(v.w);
    }
    NLOC[tid] = s;
  }
  if (tid == 0) { ((float*)(ws + OFF_BL))[h * 64 + c] = sB[127]; ((float*)(ws + OFF_CMX))[h * 64 + c] = cml; }
  __syncthreads();
}

__device__ __forceinline__ void mlstm_scan(const Params& p, int item) {
  unsigned char* ws = ows(p.ws);
  const int h = item >> 5, sl = item & 31, tid = otid(), e = sl * 256 + tid;
  const float* CLOC = (const float*)(ws + OFF_CLOC) + (size_t)h * 64 * 8192; const float* NLOC = (const float*)(ws + OFF_NLOC) + h * 64 * 64;
  const float* BL = (const float*)(ws + OFF_BL) + h * 64; const float* CMX = (const float*)(ws + OFF_CMX) + h * 64;
  bf16_t* CPREV = (bf16_t*)(ws + OFF_CPREV) + (size_t)h * 64 * 8192; float* NPREV = (float*)(ws + OFF_NPREV) + h * 64 * 64; float* MPREV = (float*)(ws + OFF_MPREV) + h * 64;
  float cst = 0.f, nst = 0.f, m = 0.f;
  const bool do_n = (sl == 0 && tid < 64);
  for (int c0 = 0; c0 < 64; c0 += 16) {
    float cl[16], bl[16], cm[16], nl[16];
#pragma unroll
    for (int j = 0; j < 16; ++j) {
      cl[j] = CLOC[(size_t)(c0 + j) * 8192 + e]; bl[j] = BL[c0 + j]; cm[j] = CMX[c0 + j];
      nl[j] = do_n ? NLOC[(c0 + j) * 64 + tid] : 0.f;
    }
#pragma unroll
    for (int j = 0; j < 16; ++j) {
      const int c = c0 + j;
      CPREV[(size_t)c * 8192 + e] = f2bf(cst);
      if (do_n) NPREV[c * 64 + tid] = nst;
      if (sl == 0 && tid == 0) MPREV[c] = m;
      const float ml = bl[j] + cm[j];
      const float mn = fmaxf(bl[j] + m, ml), so = __expf(bl[j] + m - mn), sc = __expf(ml - mn);
      cst = so * cst + sc * cl[j];
      nst = so * nst + sc * nl[j];
      m = mn;
    }
  }
}

__device__ __forceinline__ void mlstm_out(const Params& p, int l, int h, int c, unsigned char* lds) {
  unsigned char* ws = ows(p.ws);
  const float* MIF = (const float*)(ws + OFF_MIF); const bf16_t* MQ = (const bf16_t*)(ws + OFF_MQ); const bf16_t* MK = (const bf16_t*)(ws + OFF_MK);
  const bf16_t* MVT = (const bf16_t*)(ws + OFF_MVT); const bf16_t* MO = (const bf16_t*)(ws + OFF_MO); bf16_t* YB = (bf16_t*)(ws + OFF_YB);
  const bf16_t* CPREV = (const bf16_t*)(ws + OFF_CPREV) + (size_t)(h * 64 + c) * 8192; const float* NPREV = (const float*)(ws + OFF_NPREV) + (h * 64 + c) * 64;
  const float mprev = ((const float*)(ws + OFF_MPREV))[h * 64 + c];
  const float* hn = p.head_norm + l * 1024 + h * 128;
  float* sB = (float*)(lds + 65536); float* sU = sB + 128; float* sCM = sU + 128; float* sN = sCM + 128;
  const int tid = otid(), lane = tid & 63, w = tid >> 6, l15 = lane & 15, lg = lane >> 4, t0 = c * 128;
  mlstm_gates(MIF, t0, h, p.b_i[l * 8 + h], p.b_f[l * 8 + h], sB, sU, sCM);
#pragma unroll
  for (int i = 0; i < 8; ++i) {
    const int cc = tid + i * 256, dv = cc >> 4, ch = cc & 15;
    *(uint4*)(lds + swz16(dv, ch)) = *(const uint4*)(MVT + (size_t)(h * 128 + dv) * TR + t0 + ch * 8);
  }
#pragma unroll
  for (int i = 0; i < 4; ++i) {
    const int cc = tid + i * 256, dv = cc >> 3, ch = cc & 7;
    *(uint4*)(lds + 49152 + swz8(dv, ch)) = *(const uint4*)(CPREV + dv * 64 + ch * 8);
  }
  if (tid < 64) sN[tid] = NPREV[tid];
  __syncthreads();
#pragma unroll
  for (int mt = 0; mt < 2; ++mt) {
    const int tl = w * 32 + mt * 16 + l15;
    const float Mt = fmaxf(mprev, sCM[tl]), inter = __expf(mprev - Mt), bt = sB[tl];
    bf16x8 qf[2];
#pragma unroll
    for (int ks = 0; ks < 2; ++ks) qf[ks] = *(const bf16x8*)(MQ + (size_t)(t0 + tl) * 512 + h * 64 + ks * 32 + lg * 8);
    f32x4 acc[8];
#pragma unroll
    for (int dt = 0; dt < 8; ++dt) acc[dt] = (f32x4){0.f, 0.f, 0.f, 0.f};
#pragma unroll
    for (int ks = 0; ks < 2; ++ks)
#pragma unroll
      for (int dt = 0; dt < 8; ++dt) {
        const bf16x8 cf = *(const bf16x8*)(lds + 49152 + swz8(dt * 16 + l15, ks * 4 + lg));
        acc[dt] = MFMA(cf, qf[ks], acc[dt]);
      }
    float dn = 0.f;
#pragma unroll
    for (int ks = 0; ks < 2; ++ks)
#pragma unroll
      for (int j = 0; j < 8; ++j) dn += bf2f((bf16_t)qf[ks][j]) * sN[ks * 32 + lg * 8 + j];
    dn = red4(dn) * inter;
#pragma unroll
    for (int dt = 0; dt < 8; ++dt) acc[dt] *= inter;
    const int ntmax = 2 * w + mt;
    f32x4 s[8];
    float rsum = 0.f;
#pragma unroll
    for (int nt = 0; nt < 8; ++nt) {
      s[nt] = (f32x4){0.f, 0.f, 0.f, 0.f};
      if (nt <= ntmax) {
#pragma unroll
        for (int ks = 0; ks < 2; ++ks) {
          const bf16x8 kf = *(const bf16x8*)(MK + (size_t)(t0 + nt * 16 + l15) * 512 + h * 64 + ks * 32 + lg * 8);
          s[nt] = MFMA(kf, qf[ks], s[nt]);
        }
#pragma unroll
        for (int jj = 0; jj < 4; ++jj) {
          const int sl = nt * 16 + lg * 4 + jj;
          const float wv = sl <= tl ? __expf(sU[sl] - Mt) : 0.f;
          const float pv = s[nt][jj] * wv;
          s[nt][jj] = pv; rsum += pv;
        }
      }
    }
    const float den = dn + red4(rsum);
#pragma unroll
    for (int kk = 0; kk < 4; ++kk) {
      if (2 * kk <= ntmax) {
        union { bf16x8 v; unsigned u[4]; } pf;
        pf.u[0] = pk2(s[2 * kk][0], s[2 * kk][1]); pf.u[1] = pk2(s[2 * kk][2], s[2 * kk][3]);
        pf.u[2] = pk2(s[2 * kk + 1][0], s[2 * kk + 1][1]); pf.u[3] = pk2(s[2 * kk + 1][2], s[2 * kk + 1][3]);
#pragma unroll
        for (int dt = 0; dt < 8; ++dt) {
          const int row = dt * 16 + l15;
          union { bf16x8 v; uint2 h2[2]; } vf;
          vf.h2[0] = *(const uint2*)(lds + swz16(row, kk * 4 + (lg >> 1)) + (lg & 1) * 8);
          vf.h2[1] = *(const uint2*)(lds + swz16(row, kk * 4 + 2 + (lg >> 1)) + (lg & 1) * 8);
          acc[dt] = MFMA(vf.v, pf.v, acc[dt]);
        }
      }
    }
    const float mt_ = bt + Mt;
    const float inv = 1.f / fmaxf(fabsf(den), __expf(-mt_));
    float ssq = 0.f;
#pragma unroll
    for (int dt = 0; dt < 8; ++dt) { acc[dt] *= inv; ssq += acc[dt][0] * acc[dt][0] + acc[dt][1] * acc[dt][1] + acc[dt][2] * acc[dt][2] + acc[dt][3] * acc[dt][3]; }
    ssq = red4(ssq);
    const float rn = rsqrtf(ssq * (1.f / 128.f) + EPS);
#pragma unroll
    for (int dt = 0; dt < 8; ++dt) {
      const int dv = dt * 16 + lg * 4;
      const float4 g = *(const float4*)(hn + dv);
      const uint2 og = *(const uint2*)(MO + (size_t)(t0 + tl) * 1024 + h * 128 + dv);
      st4bf(YB + (size_t)(t0 + tl) * 1024 + h * 128 + dv, acc[dt][0] * rn * g.x * sigmoidf_(bflo(og.x)), acc[dt][1] * rn * g.y * sigmoidf_(bfhi(og.x)),
            acc[dt][2] * rn * g.z * sigmoidf_(bflo(og.y)), acc[dt][3] * rn * g.w * sigmoidf_(bfhi(og.y)));
    }
  }
  __syncthreads();
}

__device__ __forceinline__ void conv_item(const Params& p, int l, int item) {
  unsigned char* ws = ows(p.ws);
  const bf16_t* CONV = (const bf16_t*)(ws + OFF_CONV); bf16_t* YA = (bf16_t*)(ws + OFF_YA);
  const float* cw = p.conv_w + l * 3 * 1024;
  const int tid = otid();
#pragma unroll 2
  for (int i = 0; i < 8; ++i) {
    const int cc = tid + i * 256, t = item * 16 + (cc >> 7), c = (cc & 127) * 8;
    const uint4 gb = *(const uint4*)(CONV + (size_t)t * 3072 + c);
    float z[3][8];
#pragma unroll
    for (int d = 0; d < 3; ++d) {
      const int tt = t - 2 + d;
      if (tt >= 0) {
        const uint4 a = *(const uint4*)(CONV + (size_t)tt * 3072 + 1024 + c), u = *(const uint4*)(CONV + (size_t)tt * 3072 + 2048 + c);
        z[d][0] = bflo(a.x) * bflo(u.x); z[d][1] = bfhi(a.x) * bfhi(u.x); z[d][2] = bflo(a.y) * bflo(u.y); z[d][3] = bfhi(a.y) * bfhi(u.y);
        z[d][4] = bflo(a.z) * bflo(u.z); z[d][5] = bfhi(a.z) * bfhi(u.z); z[d][6] = bflo(a.w) * bflo(u.w); z[d][7] = bfhi(a.w) * bfhi(u.w);
      } else {
#pragma unroll
        for (int j = 0; j < 8; ++j) z[d][j] = 0.f;
      }
    }
    float y[8];
#pragma unroll
    for (int j = 0; j < 8; ++j) y[j] = cw[c + j] * z[0][j] + cw[1024 + c + j] * z[1][j] + cw[2048 + c + j] * z[2][j];
    uint4 o;
    o.x = pk2(bflo(gb.x) * y[0], bfhi(gb.x) * y[1]); o.y = pk2(bflo(gb.y) * y[2], bfhi(gb.y) * y[3]);
    o.z = pk2(bflo(gb.z) * y[4], bfhi(gb.z) * y[5]); o.w = pk2(bflo(gb.w) * y[6], bfhi(gb.w) * y[7]);
    *(uint4*)(YA + (size_t)t * 1024 + c) = o;
  }
}

constexpr float QSCALE = 0.07216878364870322f * 1.4426950408889634f;

__device__ __forceinline__ void uq_tile(const Params& p, int l, int b, int tile, unsigned char* lds) {
  unsigned char* ws = ows(p.ws);
  const bf16_t* CQ = (const bf16_t*)(ws + OFF_CQ); const bf16_t* WT = (const bf16_t*)(ws + OFF_WUQ + l * SZ_WUQ);
  const float* SSCQ = (const float*)(ws + OFF_SSCQ); bf16_t* Q = (bf16_t*)(ws + OFF_Q);
  const float* COS = (const float*)(ws + OFF_COS) + (size_t)b * TR * 32; const float* SIN = (const float*)(ws + OFF_SIN) + (size_t)b * TR * 32;
  const float* qn = p.q_norm + l * 192;
  const int mtile = tile & 63, ntile = tile >> 6;
  const int tix = otid(), lane = tix & 63, wid = tix >> 6, l15 = lane & 15, lg = lane >> 4;
  f32x4 acc[2][8];
  gemm_core<4, 1>(CQ + (size_t)mtile * 128 * 256, 256, WT + (size_t)ntile * 128 * 256, 256, 256, lds, acc);
#pragma unroll
  for (int mt = 0; mt < 2; ++mt) {
    const int row = mtile * 128 + wid * 32 + mt * 16 + l15;
    const float4 sq = *(const float4*)(SSCQ + (size_t)row * 4);
    const float ra = rsqrtf((sq.x + sq.y + sq.z + sq.w) * (1.f / 256.f) + EPS);
#pragma unroll
    for (int nt = 0; nt < 8; ++nt) acc[mt][nt] *= ra;
    if (ntile < 8) {
      float s = 0.f;
#pragma unroll
      for (int nt = 0; nt < 8; ++nt) { const f32x4 v = acc[mt][nt]; s += v[0] * v[0] + v[1] * v[1] + v[2] * v[2] + v[3] * v[3]; }
      s = red4(s);
      const float rn = rsqrtf(s * (1.f / 128.f) + EPS) * QSCALE;
#pragma unroll
      for (int nt = 0; nt < 8; ++nt) {
        const int c = nt * 16 + lg * 4; const float4 g = *(const float4*)(qn + c); const f32x4 v = acc[mt][nt];
        st4bf(Q + ((size_t)row * 8 + ntile) * 192 + c, v[0] * rn * g.x, v[1] * rn * g.y, v[2] * rn * g.z, v[3] * rn * g.w);
      }
    } else {
#pragma unroll
      for (int hf = 0; hf < 2; ++hf) {
        const int h = (ntile - 8) * 2 + hf;
        float s = 0.f;
#pragma unroll
        for (int nt = 0; nt < 4; ++nt) { const f32x4 v = acc[mt][hf * 4 + nt]; s += v[0] * v[0] + v[1] * v[1] + v[2] * v[2] + v[3] * v[3]; }
        s = red4(s);
        const float rn = rsqrtf(s * (1.f / 64.f) + EPS);
#pragma unroll
        for (int nt = 0; nt < 2; ++nt) {
          const int c = nt * 16 + lg * 4;
          const float4 cs = *(const float4*)(COS + (size_t)row * 32 + c), sn = *(const float4*)(SIN + (size_t)row * 32 + c);
          const float4 g1 = *(const float4*)(qn + 128 + c), g2 = *(const float4*)(qn + 160 + c);
          const f32x4 a = acc[mt][hf * 4 + nt], b2 = acc[mt][hf * 4 + nt + 2];
          const float x10 = a[0] * rn * g1.x, x11 = a[1] * rn * g1.y, x12 = a[2] * rn * g1.z, x13 = a[3] * rn * g1.w;
          const float x20 = b2[0] * rn * g2.x, x21 = b2[1] * rn * g2.y, x22 = b2[2] * rn * g2.z, x23 = b2[3] * rn * g2.w;
          st4bf(Q + ((size_t)row * 8 + h) * 192 + 128 + c, (x10 * cs.x - x20 * sn.x) * QSCALE, (x11 * cs.y - x21 * sn.y) * QSCALE,
                (x12 * cs.z - x22 * sn.z) * QSCALE, (x13 * cs.w - x23 * sn.w) * QSCALE);
          st4bf(Q + ((size_t)row * 8 + h) * 192 + 160 + c, (x10 * sn.x + x20 * cs.x) * QSCALE, (x11 * sn.y + x21 * cs.y) * QSCALE,
                (x12 * sn.z + x22 * cs.z) * QSCALE, (x13 * sn.w + x23 * cs.w) * QSCALE);
        }
      }
    }
  }
}

__device__ __forceinline__ void ukv_tile(const Params& p, int l, int tile, unsigned char* lds) {
  unsigned char* ws = ows(p.ws);
  const bf16_t* CKV = (const bf16_t*)(ws + OFF_CKV); const bf16_t* WT = (const bf16_t*)(ws + OFF_WUKV + l * SZ_WUKV);
  const float* SSCKV = (const float*)(ws + OFF_SSCKV); bf16_t* KB = (bf16_t*)(ws + OFF_K); bf16_t* VT = (bf16_t*)(ws + OFF_VT);
  const float* kn = p.k_norm + l * 192;
  const int mtile = tile & 63, ntile = tile >> 6;
  const int tix = otid(), lane = tix & 63, wid = tix >> 6, l15 = lane & 15, lg = lane >> 4;
  f32x4 acc[2][8];
  gemm_core<4, 1>(CKV + (size_t)mtile * 128 * 128, 128, WT + (size_t)ntile * 128 * 128, 128, 128, lds, acc);
#pragma unroll
  for (int mt = 0; mt < 2; ++mt) {
    const int row = mtile * 128 + wid * 32 + mt * 16 + l15;
    const float ra = rsqrtf((SSCKV[row * 2] + SSCKV[row * 2 + 1]) * (1.f / 128.f) + EPS);
#pragma unroll
    for (int nt = 0; nt < 8; ++nt) acc[mt][nt] *= ra;
    if (ntile < 8) {
      float s = 0.f;
#pragma unroll
      for (int nt = 0; nt < 8; ++nt) { const f32x4 v = acc[mt][nt]; s += v[0] * v[0] + v[1] * v[1] + v[2] * v[2] + v[3] * v[3]; }
      s = red4(s);
      const float rn = rsqrtf(s * (1.f / 128.f) + EPS);
#pragma unroll
      for (int nt = 0; nt < 8; ++nt) {
        const int c = nt * 16 + lg * 4; const float4 g = *(const float4*)(kn + c); const f32x4 v = acc[mt][nt];
        st4bf(KB + ((size_t)row * 8 + ntile) * 192 + c, v[0] * rn * g.x, v[1] * rn * g.y, v[2] * rn * g.z, v[3] * rn * g.w);
      }
    } else {
      const int h = ntile - 8;
#pragma unroll
      for (int nt = 0; nt < 8; ++nt)
#pragma unroll
        for (int jj = 0; jj < 4; ++jj) VT[(size_t)(h * 128 + nt * 16 + lg * 4 + jj) * TR + row] = f2bf(acc[mt][nt][jj]);
    }
  }
}

__device__ __forceinline__ void attn_item(const Params& p, int h, int qb, unsigned char* lds0) {
  unsigned char* ws = ows(p.ws); const int half = ohalf(); unsigned char* lds = lds0 + half * LDS_BYTES;
  const bf16_t* Q = (const bf16_t*)(ws + OFF_Q); const bf16_t* KB = (const bf16_t*)(ws + OFF_K); const bf16_t* VT = (const bf16_t*)(ws + OFF_VT);
  bf16_t* YC = (bf16_t*)(ws + OFF_YC);
  const int tid = otid(), lane = tid & 63, w = __builtin_amdgcn_readfirstlane(tid >> 6), l15 = lane & 15, lg = lane >> 4;
  const int r0 = qb * 128 + 32 * w;
  const int fx = (l15 >> 1) & 7, fxc = (fx & 4) << 4;
  const int kfb = l15 * 384 + ((lg ^ (fx & 3)) << 4);
  const int kfe = kfb + fxc, kfo = kfb - fxc;
  const int vfb_ = 24576 + l15 * 128 + (lg & 1) * 8, vg = lg >> 1;
  const int vfa0 = vfb_ + (((0 | vg) ^ (fx & 3)) << 4) + (0 ^ fxc), vfa1 = vfb_ + (((0 | vg) ^ (fx & 3)) << 4) + (64 ^ fxc);
  const int vfb0 = vfb_ + (((2 | vg) ^ (fx & 3)) << 4) + (0 ^ fxc), vfb1 = vfb_ + (((2 | vg) ^ (fx & 3)) << 4) + (64 ^ fxc);
  bf16x8 qf[2][6];
#pragma unroll
  for (int mt = 0; mt < 2; ++mt)
#pragma unroll
    for (int ks = 0; ks < 6; ++ks) qf[mt][ks] = *(const bf16x8*)(Q + ((size_t)(r0 + mt * 16 + l15) * 8 + h) * 192 + ks * 32 + lg * 8);
  f32x4 o[2][8];
#pragma unroll
  for (int mt = 0; mt < 2; ++mt)
#pragma unroll
    for (int dt = 0; dt < 8; ++dt) o[mt][dt] = (f32x4){0.f, 0.f, 0.f, 0.f};
  float mrun[2] = {-INFINITY, -INFINITY}, lsum[2] = {0.f, 0.f};
  const int nh = qb + 1, kt0 = half, nkt = 2 * nh;
  const int skey = tid >> 2, sq = tid & 3, sx = (skey >> 1) & 7;
  const bf16_t* kp = KB + ((size_t)skey * 8 + h) * 192 + sq * 8;
  const int klb = skey * 384 + ((sq ^ (sx & 3)) << 4), kxc = (sx >> 2) << 6;
  const int vdv = tid >> 3, vch = tid & 7;
  const bf16_t* vp = VT + (size_t)(h * 128 + vdv) * TR + vch * 8;
  const int vlo0 = 24576 + swz8(vdv, vch);
  const bf16_t* kq = kp + (size_t)kt0 * 64 * 1536; const bf16_t* vq = vp + kt0 * 64;
  uint4 sk0 = *(const uint4*)kq, sk1 = *(const uint4*)(kq + 32), sk2 = *(const uint4*)(kq + 64), sk3 = *(const uint4*)(kq + 96), sk4 = *(const uint4*)(kq + 128), sk5 = *(const uint4*)(kq + 160);
  uint4 sv0 = *(const uint4*)vq, sv1 = *(const uint4*)(vq + (size_t)32 * TR), sv2 = *(const uint4*)(vq + (size_t)64 * TR), sv3 = *(const uint4*)(vq + (size_t)96 * TR);
  for (int kt = kt0; kt < nkt; kt += 2) {
    __syncthreads();
    *(uint4*)(lds + klb + (0 ^ kxc)) = sk0; *(uint4*)(lds + klb + (64 ^ kxc)) = sk1; *(uint4*)(lds + klb + (128 ^ kxc)) = sk2;
    *(uint4*)(lds + klb + (192 ^ kxc)) = sk3; *(uint4*)(lds + klb + (256 ^ kxc)) = sk4; *(uint4*)(lds + klb + (320 ^ kxc)) = sk5;
    *(uint4*)(lds + vlo0) = sv0; *(uint4*)(lds + vlo0 + 4096) = sv1; *(uint4*)(lds + vlo0 + 8192) = sv2; *(uint4*)(lds + vlo0 + 12288) = sv3;
    __syncthreads();
    {
      const int kn = kt + 2 < nkt ? kt + 2 : kt;
      const bf16_t* k2 = kp + (size_t)kn * 64 * 1536; const bf16_t* v2 = vp + kn * 64;
      sk0 = *(const uint4*)k2; sk1 = *(const uint4*)(k2 + 32); sk2 = *(const uint4*)(k2 + 64); sk3 = *(const uint4*)(k2 + 96); sk4 = *(const uint4*)(k2 + 128); sk5 = *(const uint4*)(k2 + 160);
      sv0 = *(const uint4*)v2; sv1 = *(const uint4*)(v2 + (size_t)32 * TR); sv2 = *(const uint4*)(v2 + (size_t)64 * TR); sv3 = *(const uint4*)(v2 + (size_t)96 * TR);
    }
    if (kt * 64 <= r0 + 31) {
      f32x4 s[2][4];
#pragma unroll
      for (int mt = 0; mt < 2; ++mt) {
        const float ni = mrun[mt] == -INFINITY ? 0.f : -mrun[mt];
#pragma unroll
        for (int nt = 0; nt < 4; ++nt) s[mt][nt] = (f32x4){ni, ni, ni, ni};
      }
#pragma unroll
      for (int ks = 0; ks < 6; ++ks) {
        bf16x8 kf[4];
#pragma unroll
        for (int nt = 0; nt < 4; ++nt) kf[nt] = *(const bf16x8*)(lds + ((ks & 1) ? kfo : kfe) + nt * 6144 + ks * 64);
#pragma unroll
        for (int mt = 0; mt < 2; ++mt)
#pragma unroll
          for (int nt = 0; nt < 4; ++nt) s[mt][nt] = MFMA(kf[nt], qf[mt][ks], s[mt][nt]);
      }
      if (kt * 64 + 63 > r0) {
#pragma unroll
        for (int mt = 0; mt < 2; ++mt)
#pragma unroll
          for (int nt = 0; nt < 4; ++nt)
#pragma unroll
            for (int jj = 0; jj < 4; ++jj)
              if (kt * 64 + nt * 16 + lg * 4 + jj > r0 + mt * 16 + l15) s[mt][nt][jj] = -INFINITY;
      }
      bf16x8 pf[2][2];
#pragma unroll
      for (int mt = 0; mt < 2; ++mt) {
        float mx = -INFINITY;
#pragma unroll
        for (int nt = 0; nt < 4; ++nt) mx = fmaxf(mx, fmaxf(fmaxf(s[mt][nt][0], s[mt][nt][1]), fmaxf(s[mt][nt][2], s[mt][nt][3])));
        mx = fmaxf(mx, __shfl_xor(mx, 16)); mx = fmaxf(mx, __shfl_xor(mx, 32));
        if (__any(mx > 8.f || mrun[mt] == -INFINITY)) {
          const float d = fmaxf(mx, 0.f);
          const float base = mrun[mt] == -INFINITY ? 0.f : mrun[mt];
          const float alpha = mrun[mt] == -INFINITY ? 0.f : __builtin_amdgcn_exp2f(-d);
          mrun[mt] = base + d;
          lsum[mt] *= alpha;
#pragma unroll
          for (int dt = 0; dt < 8; ++dt) o[mt][dt] *= alpha;
#pragma unroll
          for (int nt = 0; nt < 4; ++nt) s[mt][nt] -= d;
        }
        float rsum = 0.f;
#pragma unroll
        for (int nt = 0; nt < 4; ++nt)
#pragma unroll
          for (int jj = 0; jj < 4; ++jj) { const float pv = __builtin_amdgcn_exp2f(s[mt][nt][jj]); s[mt][nt][jj] = pv; rsum += pv; }
        lsum[mt] += rsum;
#pragma unroll
        for (int kk = 0; kk < 2; ++kk) {
          union { bf16x8 v; unsigned u[4]; } t;
          t.u[0] = pk2(s[mt][2 * kk][0], s[mt][2 * kk][1]); t.u[1] = pk2(s[mt][2 * kk][2], s[mt][2 * kk][3]);
          t.u[2] = pk2(s[mt][2 * kk + 1][0], s[mt][2 * kk + 1][1]); t.u[3] = pk2(s[mt][2 * kk + 1][2], s[mt][2 * kk + 1][3]);
          pf[mt][kk] = t.v;
        }
      }
#pragma unroll
      for (int kk = 0; kk < 2; ++kk)
#pragma unroll
        for (int dt = 0; dt < 8; ++dt) {

          union { bf16x8 v; uint2 h2[2]; } vf;
          vf.h2[0] = *(const uint2*)(lds + (kk ? vfa1 : vfa0) + dt * 2048);
          vf.h2[1] = *(const uint2*)(lds + (kk ? vfb1 : vfb0) + dt * 2048);
#pragma unroll
          for (int mt = 0; mt < 2; ++mt) o[mt][dt] = MFMA(vf.v, pf[mt][kk], o[mt][dt]);
        }
    }
  }
  __syncthreads();
  unsigned char* xr = lds0 + LDS_BYTES;
  if (half == 1) {
#pragma unroll
    for (int mt = 0; mt < 2; ++mt)
#pragma unroll
      for (int dt = 0; dt < 8; ++dt) *(f32x4*)(xr + ((mt * 8 + dt) * 256 + tid) * 16) = o[mt][dt];
    *(f32x4*)(xr + 65536 + tid * 16) = (f32x4){mrun[0], mrun[1], lsum[0], lsum[1]};
  }
  __syncthreads();
  if (half == 0) {
    const f32x4 ml = *(const f32x4*)(xr + 65536 + tid * 16);
#pragma unroll
    for (int mt = 0; mt < 2; ++mt) {
      const float m1 = ml[mt], l1 = ml[2 + mt];
      const float mn = fmaxf(mrun[mt], m1);
      const float a0 = __builtin_amdgcn_exp2f(mrun[mt] - mn), a1 = __builtin_amdgcn_exp2f(m1 - mn);
      const float inv = 1.f / red4(lsum[mt] * a0 + l1 * a1);
      const int row = r0 + mt * 16 + l15;
#pragma unroll
      for (int dt = 0; dt < 8; ++dt) {
        const f32x4 o1 = *(const f32x4*)(xr + ((mt * 8 + dt) * 256 + tid) * 16);
        o[mt][dt] = (o[mt][dt] * a0 + o1 * a1) * inv;
      }
#pragma unroll
      for (int dt = 0; dt < 8; dt += 2) st_pair(YC + (size_t)row * 1024 + h * 128 + dt * 16, o[mt][dt], o[mt][dt + 1], lg);
    }
  }
}

__device__ __forceinline__ void phase4(const Params& p, int l, unsigned char* lds0) {
  unsigned char* ws = ows(p.ws); const int half = ohalf(); unsigned char* lds = lds0 + half * LDS_BYTES;
  const bf16_t* Y = (const bf16_t*)(ws + OFF_YA); const bf16_t* WT = (const bf16_t*)(ws + OFF_WBR + l * SZ_WBR);
  const bf16_t* GATES = (const bf16_t*)(ws + OFF_GATES); bf16_t* MRG = (bf16_t*)(ws + OFF_MRG); float* MRGF = (float*)(ws + OFF_CONV);
  const int tix = otid(), lane = tix & 63, wid = tix >> 6, wr = wid >> 1, wc = wid & 1, l15 = lane & 15, lg = lane >> 4;
  for (int tile = 2 * blockIdx.x + half; tile < 64 * 8; tile += 2 * gridDim.x) {
    const int mtile = tile & 63, ntile = tile >> 6;
#pragma unroll 1
    for (int br = 0; br < 3; ++br) {
      f32x4 acc[4][4];
      gemm_core<2, 2>(Y + (size_t)br * TR * 1024 + (size_t)mtile * 128 * 1024, 1024, WT + (size_t)br * 1024 * 1024 + (size_t)ntile * 128 * 1024, 1024, 1024, lds, acc);
      const int t2 = otid(), ln2 = t2 & 63, w2 = t2 >> 6;
      const int row0 = mtile * 128 + (w2 >> 1) * 64 + (ln2 & 15), col0 = ntile * 128 + (w2 & 1) * 64 + (ln2 >> 4) * 4;
      const bf16_t* gp = GATES + (size_t)row0 * 3072 + br * 1024 + col0;
      float* fp = MRGF + (size_t)row0 * 1024 + col0;
      bf16_t* op = MRG + (size_t)row0 * 1024 + col0;
#pragma unroll
      for (int mt = 0; mt < 4; ++mt) {
#pragma unroll
        for (int nt = 0; nt < 4; ++nt) {
          const uint2 g = *(const uint2*)(gp + mt * 16 * 3072 + nt * 16);
          f32x4 v;
          v[0] = bflo(g.x) * acc[mt][nt][0]; v[1] = bfhi(g.x) * acc[mt][nt][1]; v[2] = bflo(g.y) * acc[mt][nt][2]; v[3] = bfhi(g.y) * acc[mt][nt][3];
          if (br > 0) v += *(const f32x4*)(fp + mt * 16 * 1024 + nt * 16);
          if (br < 2) *(f32x4*)(fp + mt * 16 * 1024 + nt * 16) = v; else st4bf(op + mt * 16 * 1024 + nt * 16, v[0], v[1], v[2], v[3]);
        }
        asm volatile("" ::: "memory");
      }
    }
  }
}

__device__ __forceinline__ void gemm_resid(const bf16_t* A, int K, const bf16_t* WT, const float* resid, float* R, bf16_t* XBo, float* SSo, unsigned char* lds0) {
  const int half = ohalf(); unsigned char* lds = lds0 + half * LDS_BYTES;
  const int tix = otid(), lane = tix & 63, wid = tix >> 6, wr = wid >> 1, wc = wid & 1, l15 = lane & 15, lg = lane >> 4;
  for (int tile = 2 * blockIdx.x + half; tile < 64 * 8; tile += 2 * gridDim.x) {
    const int mtile = tile & 63, ntile = tile >> 6;
    const int rbase = mtile * 128 + wr * 64, cbase = ntile * 128 + wc * 64;
    f32x4 acc[4][4];
    gemm_core<2, 2>(A + (size_t)mtile * 128 * K, K, WT + (size_t)ntile * 128 * K, K, K, lds, acc);
#pragma unroll
    for (int mt = 0; mt < 4; ++mt) {
      const int row = rbase + mt * 16 + l15;
      float s = 0.f;
#pragma unroll
      for (int nt = 0; nt < 4; ++nt) {
        const size_t off = (size_t)row * 1024 + cbase + nt * 16 + lg * 4;
        const f32x4 v = *(const f32x4*)(resid + off) + acc[mt][nt];
        *(f32x4*)(R + off) = v;
        acc[mt][nt] = v;
        if (XBo) s += v[0] * v[0] + v[1] * v[1] + v[2] * v[2] + v[3] * v[3];
      }
      if (XBo) { bf16_t* rp = XBo + (size_t)row * 1024 + cbase; st_pair(rp, acc[mt][0], acc[mt][1], lg); st_pair(rp + 32, acc[mt][2], acc[mt][3], lg); }
      if (XBo) { s = red4(s); if (lg == 0) SSo[(size_t)row * 16 + ntile * 2 + wc] = s; }
    }
  }
}

__device__ __forceinline__ void phase7(const Params& p, int l, unsigned char* lds) {
  unsigned char* ws = ows(p.ws);
  const bf16_t* XB1 = (const bf16_t*)(ws + OFF_XB1); const bf16_t* WT = (const bf16_t*)(ws + OFF_WUP + l * SZ_WUP);
  const float* SS1 = (const float*)(ws + OFF_SS1); bf16_t* H = (bf16_t*)(ws + OFF_H);
  STG_DECL;
  { const int t0 = blockIdx.x < 32 * 16 ? blockIdx.x : 0; g256_issue(STG_ARGS, XB1 + (size_t)(t0 & 31) * 256 * 1024, 1024, WT + (size_t)(t0 >> 5) * 256 * 1024, 1024); }
  for (int tile = blockIdx.x; tile < 32 * 16; tile += gridDim.x) {
    const int mtile = tile & 31, ntile = tile >> 5;
    f32x4 acc[8][4];
    gemm256(XB1 + (size_t)mtile * 256 * 1024, 1024, WT + (size_t)ntile * 256 * 1024, 1024, 1024, lds, acc, STG_ARGS);
    { const int nx = tile + (int)gridDim.x < 32 * 16 ? tile + (int)gridDim.x : tile;
      g256_issue(STG_ARGS, XB1 + (size_t)(nx & 31) * 256 * 1024, 1024, WT + (size_t)(nx >> 5) * 256 * 1024, 1024); }
    const int tix = otid512(), lane = tix & 63, wid = tix >> 6, l15 = lane & 15, lg = lane >> 4;
    const int rbase = mtile * 256 + (wid >> 2) * 128, cbase = ntile * 256 + (wid & 3) * 64;
#pragma unroll
    for (int mt = 0; mt < 8; ++mt) {
      const int row = rbase + mt * 16 + l15;
      const float4* sp = (const float4*)(SS1 + (size_t)row * 16);
      const float4 a = sp[0], b2 = sp[1], c = sp[2], d = sp[3];
      const float s = (a.x + a.y + a.z + a.w) + (b2.x + b2.y + b2.z + b2.w) + (c.x + c.y + c.z + c.w) + (d.x + d.y + d.z + d.w);
      const float r = rsqrtf(s * (1.f / 1024.f) + EPS);
#pragma unroll
      for (int nt = 0; nt < 4; ++nt) {
        f32x4 v = acc[mt][nt] * r;
#pragma unroll
        for (int jj = 0; jj < 4; ++jj) { const float t = fmaxf(v[jj], 0.f); v[jj] = t * t; }
        acc[mt][nt] = v;
      }
      { bf16_t* rp = H + (size_t)row * 4096 + cbase;
        st_pair(rp, acc[mt][0], acc[mt][1], lg); st_pair(rp + 32, acc[mt][2], acc[mt][3], lg); }
    }
  }
}

#define XB_TMO      128
#define XB_XCNT(j)  (256  + 64 * (j))
#define XB_XSUB(j)  (1280 + 64 * (j))
#define XB_XGEN(j)  (2304 + 64 * (j))
#define XB_TOP      3328
#define XB_TOPGEN   3392
#define XCD_BAR_WORDS 3456
#define XB_SPIN_CAP (1u << 18)
#define LAS __attribute__((address_space(3)))

__device__ __forceinline__ unsigned xb_ld(unsigned* p)              { return __hip_atomic_load(p, __ATOMIC_RELAXED, __HIP_MEMORY_SCOPE_AGENT); }
__device__ __forceinline__ unsigned xb_add(unsigned* p, unsigned v) { return __hip_atomic_fetch_add(p, v, __ATOMIC_RELAXED, __HIP_MEMORY_SCOPE_AGENT); }
__device__ __forceinline__ unsigned xb_xcc_id() { return (unsigned)__builtin_amdgcn_s_getreg((3 << 11) | 20) & 0xFu; }
#define XB_SPIN(cond, bar) do { unsigned _sp = 0; while (cond) { __builtin_amdgcn_s_sleep(1); \
    if ((++_sp & 255u) == 0u) { if (xb_ld(&(bar)[XB_TMO])) break; if (_sp > XB_SPIN_CAP) { atomicAdd(&(bar)[XB_TMO], 1u); break; } } } } while (0)

struct XcdBarrier {
    unsigned* bar; unsigned x;
    volatile LAS unsigned* st;
};

__device__ __forceinline__ XcdBarrier xcd_barrier_post(unsigned* bar, volatile LAS unsigned* st) {
    XcdBarrier b; b.bar = bar; b.x = xb_xcc_id(); b.st = st;
    if (threadIdx.x == 0) (void)xb_add(&bar[XB_XCNT(b.x)], 1u);
    return b;
}
__device__ __forceinline__ void xcd_barrier_complete(unsigned* bar, unsigned x, unsigned& nloc, unsigned& nx) {
    const unsigned G = gridDim.x * gridDim.y * gridDim.z;
    unsigned sum, cnt, mine, sp = 0u;
    for (;;) {
        sum = 0u; cnt = 0u; mine = 0u;
#pragma unroll
        for (unsigned j = 0; j < 16; ++j) { const unsigned c = xb_ld(&bar[XB_XCNT(j)]); sum += c; cnt += (c > 0u) ? 1u : 0u; mine = (j == x) ? c : mine; }
        if (sum == G) break;
        __builtin_amdgcn_s_sleep(1);
        if ((++sp & 255u) == 0u) { if (xb_ld(&bar[XB_TMO])) break; if (sp > XB_SPIN_CAP) { atomicAdd(&bar[XB_TMO], 1u); break; } }
    }
    nloc = mine > 0u ? mine : 1u; nx = cnt > 0u ? cnt : 1u;
}

__device__ __forceinline__ void xcd_barrier(const XcdBarrier& b) {
    asm volatile("s_waitcnt vmcnt(0)" ::: "memory");
    __syncthreads();
    if (threadIdx.x == 0) {
        unsigned* bar = b.bar; const unsigned bx = xb_xcc_id();
        __builtin_amdgcn_s_waitcnt(0);
        unsigned nloc = b.st[0], nx = b.st[1];
        if (nloc == 0u) { xcd_barrier_complete(bar, bx, nloc, nx); b.st[0] = nloc; b.st[1] = nx; }
        const unsigned old = xb_add(&bar[XB_XSUB(bx)], 1u);
        const unsigned gen = old / nloc;
        if (old + 1u == (gen + 1u) * nloc) {
            __builtin_amdgcn_fence(__ATOMIC_RELEASE, "agent");
            asm volatile("s_waitcnt vmcnt(0)" ::: "memory");
            const unsigned og = xb_add(&bar[XB_TOP], 1u);
            const unsigned tg = og / nx;
            if (og + 1u == (tg + 1u) * nx) xb_add(&bar[XB_TOPGEN], 1u);
            else XB_SPIN(xb_ld(&bar[XB_TOPGEN]) == tg, bar);
            __builtin_amdgcn_fence(__ATOMIC_ACQUIRE, "agent");
            xb_add(&bar[XB_XGEN(bx)], 1u);
            asm volatile("s_waitcnt vmcnt(0)" ::: "memory");
        } else {
            XB_SPIN(xb_ld(&bar[XB_XGEN(bx)]) == gen, bar);
            __builtin_amdgcn_fence(__ATOMIC_ACQUIRE, "agent");
            asm volatile("s_waitcnt vmcnt(0)" ::: "memory");
        }
    }
    __syncthreads();
}


__global__ void __launch_bounds__(512, 2) mega(Params p) {
  cg::grid_group grid = cg::this_grid();
  extern __shared__ __attribute__((aligned(16))) unsigned char lds[];
  unsigned char* ws = ows(p.ws);
  const int half = ohalf();
  const int G = gridDim.x, bid = blockIdx.x, G2 = 2 * G, bid2 = 2 * bid + half;
  unsigned char* ldsh = lds + half * LDS_BYTES;
  volatile LAS unsigned* xst = (volatile LAS unsigned*)(lds + 2 * LDS_BYTES);
  if (threadIdx.x == 0) { xst[0] = 0u; xst[1] = 0u; }
  __syncthreads();
  XcdBarrier xb = xcd_barrier_post((unsigned*)(ws + OFF_BAR), xst);
  prologue(p, lds);
  if (p.ws == nullptr) grid.sync();
  xcd_barrier(xb);
  for (int l = 0; l < NLAYER; ++l)
    for (int b = 0; b < NBATCH; ++b) {
      phase1(p, l, b, lds);
      xcd_barrier(xb);
      for (int it = bid2; it < 768 + 1024 + 512 + 512; it += G2) {
        if (it < 768) uq_tile(p, l, b, it, ldsh);
        else if (it < 1792) ukv_tile(p, l, it - 768, ldsh);
        else if (it < 2304) mlstm_local(p, l, (it - 1792) >> 6, (it - 1792) & 63, ldsh);
        else conv_item(p, l, it - 2304);
      }
      xcd_barrier(xb);
      for (int it = G2 - 1 - bid2; it < 256; it += G2) mlstm_scan(p, it);
      for (int it = bid; it < 512; it += G) {
        const int h = it & 7, qb = it < 256 ? 63 - (it >> 3) : (it - 256) >> 3;
        attn_item(p, h, qb, lds);
      }
      xcd_barrier(xb);
      for (int it = bid2; it < 512; it += G2) mlstm_out(p, l, it >> 6, it & 63, ldsh);
      xcd_barrier(xb);
      phase4(p, l, lds);
      xcd_barrier(xb);
      {
        const float* resid = l == 0 ? p.x + (size_t)b * TR * 1024 : p.out + (size_t)b * TR * 1024;
        gemm_resid((const bf16_t*)(ws + OFF_MRG), 1024, (const bf16_t*)(ws + OFF_WOUT + l * SZ_WOUT), resid, p.out + (size_t)b * TR * 1024,
                   (bf16_t*)(ws + OFF_XB1), (float*)(ws + OFF_SS1), lds);
      }
      xcd_barrier(xb);
      phase7(p, l, lds);
      xcd_barrier(xb);
      gemm_resid((const bf16_t*)(ws + OFF_H), 4096, (const bf16_t*)(ws + OFF_WDN + l * SZ_WDN), p.out + (size_t)b * TR * 1024, p.out + (size_t)b * TR * 1024,
                 l == 0 ? (bf16_t*)(ws + OFF_XB) + (size_t)b * TR * 1024 : nullptr, (float*)(ws + OFF_SSX) + (size_t)b * TR * 16, lds);
      xcd_barrier(xb);
    }
}

extern "C" void kernel_launch(void* const* d_in, const int* in_sizes, int n_in, void* d_out, int out_size, void* d_ws, size_t ws_size, hipStream_t stream) {
  static int grid_blocks = 0;
  if (!grid_blocks) {
    int dev = 0, cus = 0, per_cu = 0;
    (void)hipGetDevice(&dev);
    (void)hipDeviceGetAttribute(&cus, hipDeviceAttributeMultiprocessorCount, dev);
    (void)hipFuncSetAttribute((const void*)mega, hipFuncAttributeMaxDynamicSharedMemorySize, (int)LDS_TOTAL);
    (void)hipOccupancyMaxActiveBlocksPerMultiprocessor(&per_cu, mega, 512, LDS_TOTAL);
    if (per_cu > 1) per_cu = 1;
    grid_blocks = cus * per_cu;
  }
  Params p{};
  p.x = (const float*)d_in[0]; p.pos = (const int*)d_in[1]; p.mix_norm = (const float*)d_in[2]; p.w_in = (const float*)d_in[3];
  p.conv_w = (const float*)d_in[4]; p.b_i = (const float*)d_in[5]; p.b_f = (const float*)d_in[6]; p.head_norm = (const float*)d_in[7];
  p.q_a_norm = (const float*)d_in[8]; p.w_uq = (const float*)d_in[9]; p.kv_a_norm = (const float*)d_in[10]; p.w_ukv = (const float*)d_in[11];
  p.q_norm = (const float*)d_in[12]; p.k_norm = (const float*)d_in[13]; p.w_branch = (const float*)d_in[14]; p.w_out = (const float*)d_in[15];
  p.mlp_norm = (const float*)d_in[16]; p.w_up = (const float*)d_in[17]; p.w_down = (const float*)d_in[18];
  p.out = (float*)d_out; p.ws = (unsigned char*)d_ws;
  (void)hipMemsetAsync((unsigned char*)d_ws + OFF_BAR, 0, XCD_BAR_WORDS * 4, stream);
  void* args[] = {&p};
  hipError_t e = hipLaunchCooperativeKernel((void*)mega, dim3(grid_blocks), dim3(512), args, LDS_TOTAL, stream);
  if (e != hipSuccess) fprintf(stderr, "cooperative launch failed: %s (grid %d)\n", hipGetErrorString(e), grid_blocks);
}
```

```cpp
#include <hip/hip_runtime.h>
#include <hip/hip_cooperative_groups.h>
#include <cstdio>
#include <cstdint>
namespace cg = cooperative_groups;

typedef unsigned short bf16_t;
typedef short bf16x8 __attribute__((ext_vector_type(8)));
typedef float f32x4 __attribute__((ext_vector_type(4)));

constexpr int TR = 8192;
constexpr int NBATCH = 4, NLAYER = 2;
constexpr int NIN = 9728;
constexpr int NIN_O = 9680;
constexpr float EPS = 1e-6f;
constexpr size_t LDS_BYTES = 73728;
constexpr size_t LDS_TOTAL = 2 * LDS_BYTES + 256;

constexpr size_t al256(size_t x) { return (x + 255) & ~(size_t)255; }
constexpr size_t SZ_WIN = (size_t)NIN * 1024 * 2, SZ_WUQ = 1536 * 256 * 2, SZ_WUKV = 2048 * 128 * 2, SZ_WBR = (size_t)3 * 1024 * 1024 * 2,
                 SZ_WOUT = 1024 * 1024 * 2, SZ_WUP = (size_t)4096 * 1024 * 2, SZ_WDN = (size_t)4096 * 1024 * 2;
constexpr size_t OFF_WIN = 0;
constexpr size_t OFF_WUQ = OFF_WIN + 2 * SZ_WIN;
constexpr size_t OFF_WUKV = OFF_WUQ + 2 * SZ_WUQ;
constexpr size_t OFF_WBR = OFF_WUKV + 2 * SZ_WUKV;
constexpr size_t OFF_WOUT = OFF_WBR + 2 * SZ_WBR;
constexpr size_t OFF_WUP = OFF_WOUT + 2 * SZ_WOUT;
constexpr size_t OFF_WDN = OFF_WUP + 2 * SZ_WUP;
constexpr size_t OFF_XB = OFF_WDN + 2 * SZ_WDN;
constexpr size_t OFF_SSX = OFF_XB + (size_t)32768 * 1024 * 2;
constexpr size_t OFF_COS = OFF_SSX + (size_t)32768 * 16 * 4;
constexpr size_t OFF_SIN = OFF_COS + (size_t)32768 * 32 * 4;
constexpr size_t OFF_CONV = OFF_SIN + (size_t)32768 * 32 * 4;
constexpr size_t OFF_GATES = OFF_CONV + (size_t)TR * 3072 * 2;
constexpr size_t OFF_H = OFF_CONV;
constexpr size_t OFF_MQ = OFF_GATES + (size_t)TR * 3072 * 2;
constexpr size_t OFF_MK = OFF_MQ + (size_t)TR * 512 * 2;
constexpr size_t OFF_MVT = OFF_MK + (size_t)TR * 512 * 2;
constexpr size_t OFF_MO = OFF_MVT + (size_t)TR * 1024 * 2;
constexpr size_t OFF_MIF = OFF_MO + (size_t)TR * 1024 * 2;
constexpr size_t OFF_CQ = OFF_MIF + (size_t)TR * 16 * 4;
constexpr size_t OFF_CKV = OFF_CQ + (size_t)TR * 256 * 2;
constexpr size_t OFF_SSCQ = OFF_CKV + (size_t)TR * 128 * 2;
constexpr size_t OFF_SSCKV = OFF_SSCQ + (size_t)TR * 4 * 4;
constexpr size_t OFF_K = OFF_SSCKV + (size_t)TR * 2 * 4;
constexpr size_t OFF_Q = OFF_K + (size_t)TR * 1536 * 2;
constexpr size_t OFF_VT = OFF_Q + (size_t)TR * 1536 * 2;
constexpr size_t OFF_YA = OFF_VT + (size_t)TR * 1024 * 2;
constexpr size_t OFF_XB1 = OFF_YA;
constexpr size_t OFF_YB = OFF_YA + (size_t)TR * 1024 * 2;
constexpr size_t OFF_YC = OFF_YB + (size_t)TR * 1024 * 2;
constexpr size_t OFF_MRG = OFF_YC + (size_t)TR * 1024 * 2;
constexpr size_t OFF_SS1 = OFF_MRG + (size_t)TR * 1024 * 2;
constexpr size_t OFF_CLOC = OFF_SS1 + (size_t)TR * 16 * 4;
constexpr size_t OFF_NLOC = OFF_CLOC + (size_t)512 * 8192 * 4;
constexpr size_t OFF_BL = OFF_NLOC + (size_t)512 * 64 * 4;
constexpr size_t OFF_CMX = OFF_BL + 512 * 4;
constexpr size_t OFF_CPREV = OFF_CMX + 512 * 4;
constexpr size_t OFF_NPREV = OFF_CPREV + (size_t)512 * 8192 * 2;
constexpr size_t OFF_MPREV = OFF_NPREV + (size_t)512 * 64 * 4;
constexpr size_t OFF_END = OFF_MPREV + 512 * 4;
constexpr size_t OFF_BAR = al256(OFF_END);
static_assert(OFF_BAR + 16384 <= (size_t)512 * 1024 * 1024, "workspace overflow");

struct Params {
  const float* x; const int* pos; const float* mix_norm; const float* w_in; const float* conv_w; const float* b_i; const float* b_f;
  const float* head_norm; const float* q_a_norm; const float* w_uq; const float* kv_a_norm; const float* w_ukv; const float* q_norm;
  const float* k_norm; const float* w_branch; const float* w_out; const float* mlp_norm; const float* w_up; const float* w_down;
  float* out; unsigned char* ws;
};

__device__ __forceinline__ unsigned pk2(float lo, float hi) { unsigned r; asm("v_cvt_pk_bf16_f32 %0, %1, %2" : "=v"(r) : "v"(lo), "v"(hi)); return r; }
__device__ __forceinline__ bf16_t f2bf(float f) { return (bf16_t)(pk2(f, 0.f) & 0xffffu); }
__device__ __forceinline__ float bf2f(bf16_t h) { return __uint_as_float(((unsigned)h) << 16); }
__device__ __forceinline__ float bflo(unsigned u) { return __uint_as_float(u << 16); }
__device__ __forceinline__ float bfhi(unsigned u) { return __uint_as_float(u & 0xffff0000u); }
__device__ __forceinline__ void st4bf(bf16_t* ptr, float a, float b, float c, float d) { uint2 v; v.x = pk2(a, b); v.y = pk2(c, d); *(uint2*)ptr = v; }
__device__ __forceinline__ float red4(float v) { v += __shfl_xor(v, 16); v += __shfl_xor(v, 32); return v; }
__device__ __forceinline__ float sigmoidf_(float x) { return 1.f / (1.f + __expf(-x)); }
__device__ __forceinline__ int swz8(int row, int ch) { return row * 128 + ((ch ^ ((row >> 1) & 7)) << 4); }
__device__ __forceinline__ int swz16(int row, int ch) { return row * 256 + ((ch ^ (row & 15)) << 4); }
__device__ __forceinline__ int otid() { int t = threadIdx.x & 255; asm volatile("" : "+v"(t)); return t; }
__device__ __forceinline__ unsigned char* ows(unsigned char* w) { unsigned z = 0; asm volatile("" : "+s"(z)); return w + z; }
__device__ __forceinline__ int otid512() { int t = threadIdx.x; asm volatile("" : "+v"(t)); return t; }
__device__ __forceinline__ int ohalf() { return __builtin_amdgcn_readfirstlane((int)(threadIdx.x >> 8)); }
__device__ __forceinline__ void st_pair(bf16_t* p, const f32x4 a, const f32x4 b, int lg) {
  const unsigned a0 = pk2(a[0], a[1]), a1 = pk2(a[2], a[3]), b0 = pk2(b[0], b[1]), b1 = pk2(b[2], b[3]);
  const bool odd = lg & 1;
  const unsigned s0 = odd ? a0 : b0, s1 = odd ? a1 : b1, k0 = odd ? b0 : a0, k1 = odd ? b1 : a1;
  const unsigned r0 = (unsigned)__shfl_xor((int)s0, 16), r1 = (unsigned)__shfl_xor((int)s1, 16);
  uint4 o;
  o.x = odd ? r0 : k0; o.y = odd ? r1 : k1; o.z = odd ? k0 : r0; o.w = odd ? k1 : r1;
  *(uint4*)(p + (odd ? 16 + (lg - 1) * 4 : lg * 4)) = o;
}
#define MFMA(a, b, c) __builtin_amdgcn_mfma_f32_16x16x32_bf16((a), (b), (c), 0, 0, 0)

template <int WM, int WN>
__device__ __forceinline__ void gemm_core(const bf16_t* __restrict__ A, int lda, const bf16_t* __restrict__ B, int ldb, int K,
                                          unsigned char* lds, f32x4 (&acc)[8 / WM][8 / WN]) {
  constexpr int MT = 8 / WM, NT = 8 / WN, RM = 128 / WM, RN = 128 / WN;
  const int tid = otid(), lane = tid & 63, wid = tid >> 6, wr = wid / WN, wc = wid % WN, l15 = lane & 15, lg = lane >> 4;
  const int lrow = tid >> 3, lch = tid & 7;
#pragma unroll
  for (int mt = 0; mt < MT; ++mt)
#pragma unroll
    for (int nt = 0; nt < NT; ++nt) acc[mt][nt] = (f32x4){0.f, 0.f, 0.f, 0.f};
  const bf16_t* Ap = A + (size_t)lrow * lda + lch * 8;
  const bf16_t* Bp = B + (size_t)lrow * ldb + lch * 8;
  const size_t sa = (size_t)32 * lda, sb = (size_t)32 * ldb;
  const int so0 = swz8(lrow, lch);
  uint4 pa0, pa1, pa2, pa3, pb0, pb1, pb2, pb3;
  uint4 qa0, qa1, qa2, qa3, qb0, qb1, qb2, qb3;
#define G_LOAD(S, kt_) do { const bf16_t* a2 = Ap + (kt_) * 64; const bf16_t* b2 = Bp + (kt_) * 64; \
    S##a0 = *(const uint4*)(a2); S##a1 = *(const uint4*)(a2 + sa); S##a2 = *(const uint4*)(a2 + 2 * sa); S##a3 = *(const uint4*)(a2 + 3 * sa); \
    S##b0 = *(const uint4*)(b2); S##b1 = *(const uint4*)(b2 + sb); S##b2 = *(const uint4*)(b2 + 2 * sb); S##b3 = *(const uint4*)(b2 + 3 * sb); } while (0)
#define G_STORE(S, buf_) do { unsigned char* d_ = lds + (buf_) * 32768 + so0; \
    *(uint4*)(d_) = S##a0; *(uint4*)(d_ + 4096) = S##a1; *(uint4*)(d_ + 8192) = S##a2; *(uint4*)(d_ + 12288) = S##a3; \
    *(uint4*)(d_ + 16384) = S##b0; *(uint4*)(d_ + 20480) = S##b1; *(uint4*)(d_ + 24576) = S##b2; *(uint4*)(d_ + 28672) = S##b3; } while (0)
#define G_COMPUTE(buf_, LOADSTMT) do { const unsigned char* cur = lds + (buf_) * 32768; \
    const unsigned char* ab = cur + swz8(wr * RM + l15, lg); const unsigned char* bb = cur + 16384 + swz8(wc * RN + l15, lg); \
    const int kx = swz8(l15, 4 + lg) - swz8(l15, lg); \
    bf16x8 a0[MT], b0[NT], a1[MT], b1[NT]; \
    _Pragma("unroll") for (int mt = 0; mt < MT; ++mt) a0[mt] = *(const bf16x8*)(ab + mt * 2048); \
    _Pragma("unroll") for (int nt = 0; nt < NT; ++nt) b0[nt] = *(const bf16x8*)(bb + nt * 2048); \
    LOADSTMT; \
    __builtin_amdgcn_sched_barrier(0); \
    _Pragma("unroll") for (int mt = 0; mt < MT; ++mt) a1[mt] = *(const bf16x8*)(ab + kx + mt * 2048); \
    _Pragma("unroll") for (int nt = 0; nt < NT; ++nt) b1[nt] = *(const bf16x8*)(bb + kx + nt * 2048); \
    _Pragma("unroll") for (int mt = 0; mt < MT; ++mt) \
      _Pragma("unroll") for (int nt = 0; nt < NT; ++nt) acc[mt][nt] = MFMA(b0[nt], a0[mt], acc[mt][nt]); \
    __builtin_amdgcn_sched_barrier(0); \
    _Pragma("unroll") for (int mt = 0; mt < MT; ++mt) \
      _Pragma("unroll") for (int nt = 0; nt < NT; ++nt) acc[mt][nt] = MFMA(b1[nt], a1[mt], acc[mt][nt]); \
    } while (0)
  const int nk = K >> 6;
  G_LOAD(p, 0);
  G_LOAD(q, 1);
  G_STORE(p, 0);
  __syncthreads();
  for (int kt = 0; kt < nk; kt += 2) {
    const int k2 = kt + 2 < nk ? kt + 2 : kt;
    G_COMPUTE(0, G_LOAD(p, k2));
    __builtin_amdgcn_sched_barrier(0);
    G_STORE(q, 1);
    __syncthreads();
    G_COMPUTE(1, G_LOAD(q, k2 + 1));
    __builtin_amdgcn_sched_barrier(0);
    G_STORE(p, 0);
    __syncthreads();
  }
#undef G_LOAD
#undef G_STORE
#undef G_COMPUTE
}

#define STG_DECL uint4 st_a0, st_a1, st_a2, st_a3, st_b0, st_b1, st_b2, st_b3
#define STG_ARGS st_a0, st_a1, st_a2, st_a3, st_b0, st_b1, st_b2, st_b3
#define STG_PARAMS uint4& st_a0, uint4& st_a1, uint4& st_a2, uint4& st_a3, uint4& st_b0, uint4& st_b1, uint4& st_b2, uint4& st_b3
__device__ __forceinline__ void g256_issue(STG_PARAMS, const bf16_t* __restrict__ A, int lda, const bf16_t* __restrict__ B, int ldb) {
  const int tid = otid512(), lrow = tid >> 3, lch = tid & 7;
  const bf16_t* a2 = A + (size_t)lrow * lda + lch * 8; const bf16_t* b2 = B + (size_t)lrow * ldb + lch * 8;
  const size_t sa = (size_t)64 * lda, sb = (size_t)64 * ldb;
  st_a0 = *(const uint4*)(a2); st_a1 = *(const uint4*)(a2 + sa); st_a2 = *(const uint4*)(a2 + 2 * sa); st_a3 = *(const uint4*)(a2 + 3 * sa);
  st_b0 = *(const uint4*)(b2); st_b1 = *(const uint4*)(b2 + sb); st_b2 = *(const uint4*)(b2 + 2 * sb); st_b3 = *(const uint4*)(b2 + 3 * sb);
}
__device__ __forceinline__ void gemm256(const bf16_t* __restrict__ A, int lda, const bf16_t* __restrict__ B, int ldb, int K, unsigned char* lds, f32x4 (&acc)[8][4], STG_PARAMS) {
  const int tid = otid512(), lane = tid & 63, wid = tid >> 6, wr = wid >> 2, wc = wid & 3, l15 = lane & 15, lg = lane >> 4;
  const int lrow = tid >> 3, lch = tid & 7;
#pragma unroll
  for (int mt = 0; mt < 8; ++mt)
#pragma unroll
    for (int nt = 0; nt < 4; ++nt) acc[mt][nt] = (f32x4){0.f, 0.f, 0.f, 0.f};
  const bf16_t* Ap = A + (size_t)lrow * lda + lch * 8;
  const bf16_t* Bp = B + (size_t)lrow * ldb + lch * 8;
  const size_t sa = (size_t)64 * lda, sb = (size_t)64 * ldb;
  const int so0 = swz8(lrow, lch);
  uint4 &pa0 = st_a0, &pa1 = st_a1, &pa2 = st_a2, &pa3 = st_a3, &pb0 = st_b0, &pb1 = st_b1, &pb2 = st_b2, &pb3 = st_b3;
#define H_LOAD(kt_) do { const bf16_t* a2 = Ap + (kt_) * 64; const bf16_t* b2 = Bp + (kt_) * 64; \
    pa0 = *(const uint4*)(a2); pa1 = *(const uint4*)(a2 + sa); pa2 = *(const uint4*)(a2 + 2 * sa); pa3 = *(const uint4*)(a2 + 3 * sa); \
    pb0 = *(const uint4*)(b2); pb1 = *(const uint4*)(b2 + sb); pb2 = *(const uint4*)(b2 + 2 * sb); pb3 = *(const uint4*)(b2 + 3 * sb); } while (0)
#define H_STORE(buf_) do { unsigned char* d_ = lds + (buf_) * 65536 + so0; \
    *(uint4*)(d_) = pa0; *(uint4*)(d_ + 8192) = pa1; *(uint4*)(d_ + 16384) = pa2; *(uint4*)(d_ + 24576) = pa3; \
    *(uint4*)(d_ + 32768) = pb0; *(uint4*)(d_ + 40960) = pb1; *(uint4*)(d_ + 49152) = pb2; *(uint4*)(d_ + 57344) = pb3; } while (0)
  const int nk = K >> 6;
  H_STORE(0);
  H_LOAD(1);
  __syncthreads();
  for (int kt = 0; kt < nk; ++kt) {
    const unsigned char* cur = lds + (kt & 1) * 65536;
    unsigned char* nx_ = lds + ((kt + 1) & 1) * 65536 + so0;
    const int k2 = kt + 2 < nk ? kt + 2 : kt;
    const bf16_t* a2 = Ap + k2 * 64; const bf16_t* b2 = Bp + k2 * 64;
#define RS_A(r, i) do { *(uint4*)(nx_ + (i) * 8192) = r; r = *(const uint4*)(a2 + (i) * sa); } while (0)
#define RS_B(r, i) do { *(uint4*)(nx_ + 32768 + (i) * 8192) = r; r = *(const uint4*)(b2 + (i) * sb); } while (0)
    {
      const unsigned char* ab = cur + swz8(wr * 128 + l15, lg);
      const unsigned char* bb = cur + 32768 + swz8(wc * 64 + l15, lg);
      const int kx = (swz8(l15, 4 + lg) - swz8(l15, lg));
      bf16x8 b0[4], b1[4], aA[4], aB[4];
#define LDB(dst, off) _Pragma("unroll") for (int nt = 0; nt < 4; ++nt) dst[nt] = *(const bf16x8*)(bb + (off) + nt * 2048)
#define LDA(dst, off, mh) _Pragma("unroll") for (int m = 0; m < 4; ++m) dst[m] = *(const bf16x8*)(ab + (off) + ((mh) * 4 + m) * 2048)
#define MMA(aX, bX, mh) _Pragma("unroll") for (int m = 0; m < 4; ++m) _Pragma("unroll") for (int nt = 0; nt < 4; ++nt) acc[(mh) * 4 + m][nt] = MFMA(bX[nt], aX[m], acc[(mh) * 4 + m][nt])
      LDB(b0, 0); LDA(aA, 0, 0);
      __builtin_amdgcn_sched_barrier(0);
      LDA(aB, 0, 1);
      RS_A(pa0, 0); RS_A(pa1, 1); RS_A(pa2, 2);
      MMA(aA, b0, 0);
      __builtin_amdgcn_sched_barrier(0);
      LDB(b1, kx); LDA(aA, kx, 0);
      RS_A(pa3, 3); RS_B(pb0, 0); RS_B(pb1, 1);
      MMA(aB, b0, 1);
      __builtin_amdgcn_sched_barrier(0);
      LDA(aB, kx, 1);
      RS_B(pb2, 2); RS_B(pb3, 3);
      MMA(aA, b1, 0);
      __builtin_amdgcn_sched_barrier(0);
      MMA(aB, b1, 1);
#undef LDB
#undef LDA
#undef MMA
    }
#undef RS_A
#undef RS_B
    __builtin_amdgcn_sched_barrier(0);
    __syncthreads();
  }
#undef H_LOAD
#undef H_STORE
}

__device__ __forceinline__ void gemm256x128(const bf16_t* __restrict__ A, int lda, const bf16_t* __restrict__ B, int ldb, int K, unsigned char* lds, f32x4 (&acc)[4][4]) {
  const int tid = otid512(), lane = tid & 63, wid = tid >> 6, wr = wid >> 1, wc = wid & 1, l15 = lane & 15, lg = lane >> 4;
  const int lrow = tid >> 3, lch = tid & 7;
#pragma unroll
  for (int mt = 0; mt < 4; ++mt)
#pragma unroll
    for (int nt = 0; nt < 4; ++nt) acc[mt][nt] = (f32x4){0.f, 0.f, 0.f, 0.f};
  const bf16_t* Ap = A + (size_t)lrow * lda + lch * 8;
  const bf16_t* Bp = B + (size_t)lrow * ldb + lch * 8;
  const size_t sa = (size_t)64 * lda, sb = (size_t)64 * ldb;
  const int so0 = swz8(lrow, lch);
  uint4 pa0, pa1, pa2, pa3, pb0, pb1;
  const int nk = K >> 6;
  pa0 = *(const uint4*)(Ap); pa1 = *(const uint4*)(Ap + sa); pa2 = *(const uint4*)(Ap + 2 * sa); pa3 = *(const uint4*)(Ap + 3 * sa);
  pb0 = *(const uint4*)(Bp); pb1 = *(const uint4*)(Bp + sb);
  { unsigned char* d_ = lds + so0;
    *(uint4*)(d_) = pa0; *(uint4*)(d_ + 8192) = pa1; *(uint4*)(d_ + 16384) = pa2; *(uint4*)(d_ + 24576) = pa3;
    *(uint4*)(d_ + 32768) = pb0; *(uint4*)(d_ + 40960) = pb1; }
  pa0 = *(const uint4*)(Ap + 64); pa1 = *(const uint4*)(Ap + sa + 64); pa2 = *(const uint4*)(Ap + 2 * sa + 64); pa3 = *(const uint4*)(Ap + 3 * sa + 64);
  pb0 = *(const uint4*)(Bp + 64); pb1 = *(const uint4*)(Bp + sb + 64);
  __syncthreads();
  const int abo = swz8(wr * 64 + l15, lg), bbo = 32768 + swz8(wc * 64 + l15, lg);
  const int kx = (swz8(l15, 4 + lg) - swz8(l15, lg));
  for (int kt = 0; kt < nk; ++kt) {
    const unsigned char* cur = lds + (kt & 1) * 49152;
    unsigned char* nx_ = lds + ((kt + 1) & 1) * 49152 + so0;
    const int k2 = kt + 2 < nk ? kt + 2 : kt;
    const bf16_t* a2 = Ap + k2 * 64; const bf16_t* b2 = Bp + k2 * 64;
    bf16x8 a0[4], b0[4], a1[4], b1[4];
#pragma unroll
    for (int m = 0; m < 4; ++m) a0[m] = *(const bf16x8*)(cur + abo + m * 2048);
#pragma unroll
    for (int n = 0; n < 4; ++n) b0[n] = *(const bf16x8*)(cur + bbo + n * 2048);
    __builtin_amdgcn_sched_barrier(0);
#pragma unroll
    for (int m = 0; m < 4; ++m) a1[m] = *(const bf16x8*)(cur + abo + kx + m * 2048);
#pragma unroll
    for (int n = 0; n < 4; ++n) b1[n] = *(const bf16x8*)(cur + bbo + kx + n * 2048);
    *(uint4*)(nx_) = pa0; pa0 = *(const uint4*)(a2);
    *(uint4*)(nx_ + 8192) = pa1; pa1 = *(const uint4*)(a2 + sa);
    *(uint4*)(nx_ + 16384) = pa2; pa2 = *(const uint4*)(a2 + 2 * sa);
#pragma unroll
    for (int m = 0; m < 4; ++m)
#pragma unroll
      for (int n = 0; n < 4; ++n) acc[m][n] = MFMA(b0[n], a0[m], acc[m][n]);
    __builtin_amdgcn_sched_barrier(0);
    *(uint4*)(nx_ + 24576) = pa3; pa3 = *(const uint4*)(a2 + 3 * sa);
    *(uint4*)(nx_ + 32768) = pb0; pb0 = *(const uint4*)(b2);
    *(uint4*)(nx_ + 40960) = pb1; pb1 = *(const uint4*)(b2 + sb);
#pragma unroll
    for (int m = 0; m < 4; ++m)
#pragma unroll
      for (int n = 0; n < 4; ++n) acc[m][n] = MFMA(b1[n], a1[m], acc[m][n]);
    __builtin_amdgcn_sched_barrier(0);
    __syncthreads();
  }
}

__device__ __forceinline__ int map_in(int n) {
  if (n < 6144) return n;
  if (n < 6592) return n + 16;
  if (n < 6608) return n - 448;
  if (n < 6656) return -1;
  return n - 48;
}
__device__ __forceinline__ int map_uq(int n) { return n < 1024 ? (n >> 7) * 192 + (n & 127) : ((n - 1024) >> 6) * 192 + 128 + ((n - 1024) & 63); }
__device__ __forceinline__ int map_ukv(int n) { return n < 1024 ? (n >> 7) * 256 + (n & 127) : ((n - 1024) >> 7) * 256 + 128 + ((n - 1024) & 127); }

__device__ __forceinline__ void transpose_tile(const float* __restrict__ W, int NO, int K, bf16_t* __restrict__ out, int N, int MAP, const float* __restrict__ gain,
                               int tile, float* ldsf) {
  const int ntn = N >> 6, n0 = (tile % ntn) << 6, k0 = (tile / ntn) << 6;
  const int tl = threadIdx.x & 255;
  {
    const int r = tl >> 4, c4 = (tl & 15) * 4, n = n0 + c4;
    const int o = MAP == 0 ? n : MAP == 1 ? map_in(n) : MAP == 2 ? map_uq(n) : map_ukv(n);
#pragma unroll
    for (int i = 0; i < 4; ++i) {
      const int k = k0 + r + 16 * i;
      float4 v = o >= 0 ? *(const float4*)(W + (size_t)k * NO + o) : make_float4(0.f, 0.f, 0.f, 0.f);
      if (gain) { const float g = gain[k]; v.x *= g; v.y *= g; v.z *= g; v.w *= g; }
      *(float4*)(ldsf + (r + 16 * i) * 68 + c4) = v;
    }
  }
  __syncthreads();
  {
    const int nn = tl >> 2, kq = tl & 3;
#pragma unroll
    for (int j = 0; j < 2; ++j) {
      const int kk = (kq + 4 * j) * 8;
      uint4 o;
      o.x = pk2(ldsf[(kk + 0) * 68 + nn], ldsf[(kk + 1) * 68 + nn]); o.y = pk2(ldsf[(kk + 2) * 68 + nn], ldsf[(kk + 3) * 68 + nn]);
      o.z = pk2(ldsf[(kk + 4) * 68 + nn], ldsf[(kk + 5) * 68 + nn]); o.w = pk2(ldsf[(kk + 6) * 68 + nn], ldsf[(kk + 7) * 68 + nn]);
      *(uint4*)(out + (size_t)(n0 + nn) * K + k0 + kk) = o;
    }
  }
  __syncthreads();
}

__device__ __forceinline__ void prologue(const Params& p, unsigned char* lds) {
  const int half = ohalf();
  float* ldsf = (float*)(lds + half * LDS_BYTES);
  unsigned char* ws = ows(p.ws);
  const int G = 2 * gridDim.x, bid = 2 * blockIdx.x + half, tid = threadIdx.x & 255;
  constexpr int TL = 2432 + 96 + 64 + 768 + 256 + 1024 + 1024;
  for (int it = bid; it < 2 * TL; it += G) {
    const int l = it / TL; int r = it % TL;
    if (r < 2432) { transpose_tile(p.w_in + (size_t)l * 1024 * NIN_O, NIN_O, 1024, (bf16_t*)(ws + OFF_WIN + l * SZ_WIN), NIN, 1, p.mix_norm + l * 1024, r, ldsf); continue; }
    r -= 2432;
    if (r < 96) { transpose_tile(p.w_uq + (size_t)l * 256 * 1536, 1536, 256, (bf16_t*)(ws + OFF_WUQ + l * SZ_WUQ), 1536, 2, p.q_a_norm + l * 256, r, ldsf); continue; }
    r -= 96;
    if (r < 64) { transpose_tile(p.w_ukv + (size_t)l * 128 * 2048, 2048, 128, (bf16_t*)(ws + OFF_WUKV + l * SZ_WUKV), 2048, 3, p.kv_a_norm + l * 128, r, ldsf); continue; }
    r -= 64;
    if (r < 768) { const int br = r >> 8; transpose_tile(p.w_branch + ((size_t)l * 3 + br) * 1024 * 1024, 1024, 1024, (bf16_t*)(ws + OFF_WBR + l * SZ_WBR) + (size_t)br * 1024 * 1024, 1024, 0, nullptr, r & 255, ldsf); continue; }
    r -= 768;
    if (r < 256) { transpose_tile(p.w_out + (size_t)l * 1024 * 1024, 1024, 1024, (bf16_t*)(ws + OFF_WOUT + l * SZ_WOUT), 1024, 0, nullptr, r, ldsf); continue; }
    r -= 256;
    if (r < 1024) { transpose_tile(p.w_up + (size_t)l * 1024 * 4096, 4096, 1024, (bf16_t*)(ws + OFF_WUP + l * SZ_WUP), 4096, 0, p.mlp_norm + l * 1024, r, ldsf); continue; }
    r -= 1024;
    transpose_tile(p.w_down + (size_t)l * 4096 * 1024, 1024, 4096, (bf16_t*)(ws + OFF_WDN + l * SZ_WDN), 1024, 0, nullptr, r, ldsf);
  }
  {
    bf16_t* XB = (bf16_t*)(ws + OFF_XB); float* SSX = (float*)(ws + OFF_SSX);
    for (int it = bid; it < 16384; it += G) {
      const int t = it * 2 + (tid >> 7), c = (tid & 127) * 8;
      const float4 a = *(const float4*)(p.x + (size_t)t * 1024 + c), b = *(const float4*)(p.x + (size_t)t * 1024 + c + 4);
      uint4 o; o.x = pk2(a.x, a.y); o.y = pk2(a.z, a.w); o.z = pk2(b.x, b.y); o.w = pk2(b.z, b.w);
      *(uint4*)(XB + (size_t)t * 1024 + c) = o;
      float s = a.x * a.x + a.y * a.y + a.z * a.z + a.w * a.w + b.x * b.x + b.y * b.y + b.z * b.z + b.w * b.w;
      s += __shfl_xor(s, 1); s += __shfl_xor(s, 2); s += __shfl_xor(s, 4);
      if ((tid & 7) == 0) SSX[(size_t)t * 16 + (c >> 6)] = s;
    }
  }
  {
    float* COS = (float*)(ws + OFF_COS); float* SIN = (float*)(ws + OFF_SIN);
    for (int it = bid; it < 4096; it += G) {
      const int e = it * 256 + tid, t = e >> 5, i = e & 31;
      const float invf = (float)exp(-(double)i * (9.210340371976184 / 32.0));
      const float ang = (float)p.pos[t] * invf;
      double a = (double)ang;
      const double n = rint(a * 0.15915494309189535);
      double r = a - n * 6.283185307179586477;
      const double r2 = r * r;
      double sn = 1.0 / 1.5511210043330986e25, cs = 1.0 / 6.2044840173323944e23;
      sn = 1.0 / 2.5852016738884978e22 - sn * r2; cs = 1.0 / 1.1240007277776077e21 - cs * r2;
      sn = 1.0 / 5.109094217170944e19 - sn * r2;  cs = 1.0 / 2.43290200817664e18 - cs * r2;
      sn = 1.0 / 1.21645100408832e17 - sn * r2;   cs = 1.0 / 6.402373705728e15 - cs * r2;
      sn = 1.0 / 3.55687428096e14 - sn * r2;      cs = 1.0 / 2.0922789888e13 - cs * r2;
      sn = 1.0 / 1.307674368e12 - sn * r2;        cs = 1.0 / 8.71782912e10 - cs * r2;
      sn = 1.0 / 6227020800.0 - sn * r2;          cs = 1.0 / 479001600.0 - cs * r2;
      sn = 1.0 / 39916800.0 - sn * r2;            cs = 1.0 / 3628800.0 - cs * r2;
      sn = 1.0 / 362880.0 - sn * r2;              cs = 1.0 / 40320.0 - cs * r2;
      sn = 1.0 / 5040.0 - sn * r2;                cs = 1.0 / 720.0 - cs * r2;
      sn = 1.0 / 120.0 - sn * r2;                 cs = 1.0 / 24.0 - cs * r2;
      sn = 1.0 / 6.0 - sn * r2;                   cs = 1.0 / 2.0 - cs * r2;
      sn = 1.0 - sn * r2;                         cs = 1.0 - cs * r2;
      sn *= r;
      COS[e] = (float)cs; SIN[e] = (float)sn;
    }
  }
}

__device__ __forceinline__ void phase1(const Params& p, int l, int b, unsigned char* lds) {
  unsigned char* ws = ows(p.ws);
  const bf16_t* XB = (const bf16_t*)(ws + OFF_XB) + (size_t)b * TR * 1024;
  const float* SSX = (const float*)(ws + OFF_SSX) + (size_t)b * TR * 16;
  const float* COS = (const float*)(ws + OFF_COS) + (size_t)b * TR * 32;
  const float* SIN = (const float*)(ws + OFF_SIN) + (size_t)b * TR * 32;
  const bf16_t* WT = (const bf16_t*)(ws + OFF_WIN + l * SZ_WIN);
  bf16_t* CONV = (bf16_t*)(ws + OFF_CONV); bf16_t* GATES = (bf16_t*)(ws + OFF_GATES);
  bf16_t* MQ = (bf16_t*)(ws + OFF_MQ); bf16_t* MK = (bf16_t*)(ws + OFF_MK); bf16_t* MVT = (bf16_t*)(ws + OFF_MVT); bf16_t* MO = (bf16_t*)(ws + OFF_MO);
  float* MIF = (float*)(ws + OFF_MIF); bf16_t* CQ = (bf16_t*)(ws + OFF_CQ); bf16_t* CKV = (bf16_t*)(ws + OFF_CKV);
  float* SSCQ = (float*)(ws + OFF_SSCQ); float* SSCKV = (float*)(ws + OFF_SSCKV); bf16_t* KB = (bf16_t*)(ws + OFF_K);
  const float* knorm = p.k_norm + l * 192;
  STG_DECL;
  { const int t0 = blockIdx.x < 32 * 38 ? blockIdx.x : 0; g256_issue(STG_ARGS, XB + (size_t)(t0 & 31) * 256 * 1024, 1024, WT + (size_t)(t0 >> 5) * 256 * 1024, 1024); }
  for (int tile = blockIdx.x; tile < 32 * 38; tile += gridDim.x) {
    const int mtile = tile & 31, ntile = tile >> 5;
    f32x4 acc[8][4];
    gemm256(XB + (size_t)mtile * 256 * 1024, 1024, WT + (size_t)ntile * 256 * 1024, 1024, 1024, lds, acc, STG_ARGS);
    const int tix = otid512(), lane = tix & 63, wid = tix >> 6, l15 = lane & 15, lg = lane >> 4;
    const int rbase = mtile * 256 + (wid >> 2) * 128;
    const int colw = __builtin_amdgcn_readfirstlane(ntile * 256 + (wid & 3) * 64);
#pragma unroll
    for (int mt = 0; mt < 8; ++mt) {
      const float4* sp = (const float4*)(SSX + (size_t)(rbase + mt * 16 + l15) * 16);
      const float4 a = sp[0], b2 = sp[1], c = sp[2], d = sp[3];
      const float s = (a.x + a.y + a.z + a.w) + (b2.x + b2.y + b2.z + b2.w) + (c.x + c.y + c.z + c.w) + (d.x + d.y + d.z + d.w);
      const float rs = rsqrtf(s * (1.f / 1024.f) + EPS);
#pragma unroll
      for (int nt = 0; nt < 4; ++nt) acc[mt][nt] *= rs;
    }
    {
      const int nx = tile + (int)gridDim.x < 32 * 38 ? tile + (int)gridDim.x : tile;
      g256_issue(STG_ARGS, XB + (size_t)(nx & 31) * 256 * 1024, 1024, WT + (size_t)(nx >> 5) * 256 * 1024, 1024);
    }
    if (colw < 3072 || (colw >= 5120 && colw < 6144) || colw >= 6656) {
      bf16_t* dst; int ld, c0;
      if (colw < 3072) { dst = CONV; ld = 3072; c0 = colw; }
      else if (colw < 6144) { dst = MO; ld = 1024; c0 = colw - 5120; }
      else { dst = GATES; ld = 3072; c0 = colw - 6656; }
      const bool sg = colw >= 6656;
#pragma unroll
      for (int mt = 0; mt < 8; ++mt) {
        if (sg) {
#pragma unroll
          for (int nt = 0; nt < 4; ++nt) { f32x4 v = acc[mt][nt]; v[0] = sigmoidf_(v[0]); v[1] = sigmoidf_(v[1]); v[2] = sigmoidf_(v[2]); v[3] = sigmoidf_(v[3]); acc[mt][nt] = v; }
        }
        bf16_t* rp = dst + (size_t)(rbase + mt * 16 + l15) * ld + c0;
        st_pair(rp, acc[mt][0], acc[mt][1], lg); st_pair(rp + 32, acc[mt][2], acc[mt][3], lg);
      }
    } else if (colw < 4096) {
      bf16_t* dst = colw < 3584 ? MQ : MK; const int c0 = colw < 3584 ? colw - 3072 : colw - 3584; const float sc = colw < 3584 ? 0.125f : 1.f;
#pragma unroll
      for (int mt = 0; mt < 8; ++mt) {
        bf16_t* rp = dst + (size_t)(rbase + mt * 16 + l15) * 512 + c0;
        st_pair(rp, acc[mt][0] * sc, acc[mt][1] * sc, lg); st_pair(rp + 32, acc[mt][2] * sc, acc[mt][3] * sc, lg);
      }
    } else if (colw < 5120) {
      const int c0 = colw - 4096;
#pragma unroll
      for (int mt = 0; mt < 8; ++mt)
#pragma unroll
        for (int nt = 0; nt < 4; ++nt)
#pragma unroll
          for (int jj = 0; jj < 4; ++jj)
            MVT[(size_t)(c0 + nt * 16 + lg * 4 + jj) * TR + rbase + mt * 16 + l15] = f2bf(acc[mt][nt][jj]);
    } else if (colw < 6528) {
      const bool iscq = colw < 6400;
      bf16_t* dst = iscq ? CQ : CKV; const int ld = iscq ? 256 : 128; const int c0 = iscq ? colw - 6144 : colw - 6400;
#pragma unroll
      for (int mt = 0; mt < 8; ++mt) {
        float s = 0.f;
#pragma unroll
        for (int nt = 0; nt < 4; ++nt) {
          const f32x4 v = acc[mt][nt];
          s += v[0] * v[0] + v[1] * v[1] + v[2] * v[2] + v[3] * v[3];
        }
        { bf16_t* rp = dst + (size_t)(rbase + mt * 16 + l15) * ld + c0;
          st_pair(rp, acc[mt][0], acc[mt][1], lg); st_pair(rp + 32, acc[mt][2], acc[mt][3], lg); }
        s = red4(s);
        if (lg == 0) {
          const int row = rbase + mt * 16 + l15;
          if (iscq) SSCQ[row * 4 + (c0 >> 6)] = s; else SSCKV[row * 2 + (c0 >> 6)] = s;
        }
      }
    } else if (colw == 6528) {
#pragma unroll
      for (int mt = 0; mt < 8; ++mt) {
        const int row = rbase + mt * 16 + l15;
        float s = 0.f;
#pragma unroll
        for (int nt = 0; nt < 4; ++nt) { const f32x4 v = acc[mt][nt]; s += v[0] * v[0] + v[1] * v[1] + v[2] * v[2] + v[3] * v[3]; }
        s = red4(s);
        const float rn = rsqrtf(s * (1.f / 64.f) + EPS);
#pragma unroll
        for (int nt = 0; nt < 2; ++nt) {
          const int c = nt * 16 + lg * 4;
          const float4 cs = *(const float4*)(COS + (size_t)row * 32 + c), sn = *(const float4*)(SIN + (size_t)row * 32 + c);
          const float4 g1 = *(const float4*)(knorm + 128 + c), g2 = *(const float4*)(knorm + 160 + c);
          const f32x4 a = acc[mt][nt], b2 = acc[mt][nt + 2];
          const float x10 = a[0] * rn * g1.x, x11 = a[1] * rn * g1.y, x12 = a[2] * rn * g1.z, x13 = a[3] * rn * g1.w;
          const float x20 = b2[0] * rn * g2.x, x21 = b2[1] * rn * g2.y, x22 = b2[2] * rn * g2.z, x23 = b2[3] * rn * g2.w;
          uint2 o1, o2;
          o1.x = pk2(x10 * cs.x - x20 * sn.x, x11 * cs.y - x21 * sn.y); o1.y = pk2(x12 * cs.z - x22 * sn.z, x13 * cs.w - x23 * sn.w);
          o2.x = pk2(x10 * sn.x + x20 * cs.x, x11 * sn.y + x21 * cs.y); o2.y = pk2(x12 * sn.z + x22 * cs.z, x13 * sn.w + x23 * cs.w);
#pragma unroll
          for (int h = 0; h < 8; ++h) {
            *(uint2*)(KB + ((size_t)row * 8 + h) * 192 + 128 + c) = o1;
            *(uint2*)(KB + ((size_t)row * 8 + h) * 192 + 160 + c) = o2;
          }
        }
      }
    } else {
#pragma unroll
      for (int mt = 0; mt < 8; ++mt) *(f32x4*)(MIF + (size_t)(rbase + mt * 16 + l15) * 16 + lg * 4) = acc[mt][0];
    }
  }
}

__device__ __forceinline__ void mlstm_gates(const float* __restrict__ MIF, int t0, int h, float bi, float bf, float* sB, float* sU, float* sCM) {
  const int tid = otid();
  if (tid < 128) {
    const float ip = MIF[(size_t)(t0 + tid) * 16 + h] + bi, fp = MIF[(size_t)(t0 + tid) * 16 + 8 + h] + bf;
    const float li = 15.f * tanhf(ip * (1.f / 15.f));
    const float fc = 15.f * tanhf(fp * (1.f / 15.f));
    const float lf = fminf(fc, 0.f) - log1pf(expf(-fabsf(fc)));
    sU[tid] = li; sB[tid] = lf;
  }
  __syncthreads();
  if (tid < 64) {
    const float f0 = sB[2 * tid], f1 = sB[2 * tid + 1], i0 = sU[2 * tid], i1 = sU[2 * tid + 1];
    float v = f0 + f1;
#pragma unroll
    for (int d = 1; d < 64; d <<= 1) { const float o = __shfl_up(v, d); if (tid >= d) v += o; }
    const float b1 = v, b0 = v - f1;
    const float u0 = i0 - b0, u1 = i1 - b1;
    float m = fmaxf(u0, u1);
#pragma unroll
    for (int d = 1; d < 64; d <<= 1) { const float o = __shfl_up(m, d); if (tid >= d) m = fmaxf(m, o); }
    float mprev = __shfl_up(m, 1); if (tid == 0) mprev = -INFINITY;
    sB[2 * tid] = b0; sB[2 * tid + 1] = b1; sU[2 * tid] = u0; sU[2 * tid + 1] = u1;
    sCM[2 * tid] = fmaxf(mprev, u0); sCM[2 * tid + 1] = m;
  }
  __syncthreads();
}

__device__ __forceinline__ void mlstm_local(const Params& p, int l, int h, int c, unsigned char* lds) {
  unsigned char* ws = ows(p.ws);
  const float* MIF = (const float*)(ws + OFF_MIF); const bf16_t* MK = (const bf16_t*)(ws + OFF_MK); const bf16_t* MVT = (const bf16_t*)(ws + OFF_MVT);
  float* CLOC = (float*)(ws + OFF_CLOC) + (size_t)(h * 64 + c) * 8192; float* NLOC = (float*)(ws + OFF_NLOC) + (h * 64 + c) * 64;
  float* sB = (float*)(lds + 65536); float* sU = sB + 128; float* sCM = sU + 128;
  const int tid = otid(), lane = tid & 63, w = tid >> 6, l15 = lane & 15, lg = lane >> 4, t0 = c * 128;
  mlstm_gates(MIF, t0, h, p.b_i[l * 8 + h], p.b_f[l * 8 + h], sB, sU, sCM);
  const float cml = sCM[127];
#pragma unroll
  for (int i = 0; i < 8; ++i) {
    const int cc = tid + i * 256, dv = cc >> 4, ch = cc & 15;
    *(uint4*)(lds + swz16(dv, ch)) = *(const uint4*)(MVT + (size_t)(h * 128 + dv) * TR + t0 + ch * 8);
  }
#pragma unroll
  for (int i = 0; i < 4; ++i) {
    const int cc = tid + i * 256, s = cc >> 3, kc = cc & 7;
    const uint4 kv = *(const uint4*)(MK + (size_t)(t0 + s) * 512 + h * 64 + kc * 8);
    const float wgt = __expf(sU[s] - cml);
    const unsigned u[4] = {kv.x, kv.y, kv.z, kv.w};
#pragma unroll
    for (int j = 0; j < 4; ++j) {
      const int k0 = kc * 8 + 2 * j;
      *(bf16_t*)(lds + 32768 + swz16(k0, s >> 3) + (s & 7) * 2) = f2bf(bflo(u[j]) * wgt);
      *(bf16_t*)(lds + 32768 + swz16(k0 + 1, s >> 3) + (s & 7) * 2) = f2bf(bfhi(u[j]) * wgt);
    }
  }
  __syncthreads();
  f32x4 acc[2][4];
#pragma unroll
  for (int dt = 0; dt < 2; ++dt)
#pragma unroll
    for (int kt = 0; kt < 4; ++kt) acc[dt][kt] = (f32x4){0.f, 0.f, 0.f, 0.f};
#pragma unroll
  for (int ss = 0; ss < 4; ++ss) {
    bf16x8 vf[2], kf[4];
#pragma unroll
    for (int dt = 0; dt < 2; ++dt) vf[dt] = *(const bf16x8*)(lds + swz16(w * 32 + dt * 16 + l15, ss * 4 + lg));
#pragma unroll
    for (int kt = 0; kt < 4; ++kt) kf[kt] = *(const bf16x8*)(lds + 32768 + swz16(kt * 16 + l15, ss * 4 + lg));
#pragma unroll
    for (int dt = 0; dt < 2; ++dt)
#pragma unroll
      for (int kt = 0; kt < 4; ++kt) acc[dt][kt] = MFMA(vf[dt], kf[kt], acc[dt][kt]);
  }
#pragma unroll
  for (int dt = 0; dt < 2; ++dt)
#pragma unroll
    for (int kt = 0; kt < 4; ++kt)
#pragma unroll
      for (int jj = 0; jj < 4; ++jj) CLOC[(w * 32 + dt * 16 + lg * 4 + jj) * 64 + kt * 16 + l15] = acc[dt][kt][jj];
  if (tid < 64) {
    float s = 0.f;
    for (int ch = 0; ch < 16; ++ch) {
      const uint4 v = *(const uint4*)(lds + 32768 + swz16(tid, ch));
      s += bflo(v.x) + bfhi(v.x) + bflo(v.y) + bfhi(v.y) + bflo(v.z) + bfhi(v.z) + bflo(v.w) + bfhi(v.w);
    }
    NLOC[tid] = s;
  }
  if (tid == 0) { ((float*)(ws + OFF_BL))[h * 64 + c] = sB[127]; ((float*)(ws + OFF_CMX))[h * 64 + c] = cml; }
  __syncthreads();
}

__device__ __forceinline__ void mlstm_scan(const Params& p, int item) {
  unsigned char* ws = ows(p.ws);
  const int h = item >> 5, sl = item & 31, tid = otid(), e = sl * 256 + tid;
  const float* CLOC = (const float*)(ws + OFF_CLOC) + (size_t)h * 64 * 8192; const float* NLOC = (const float*)(ws + OFF_NLOC) + h * 64 * 64;
  const float* BL = (const float*)(ws + OFF_BL) + h * 64; const float* CMX = (const float*)(ws + OFF_CMX) + h * 64;
  bf16_t* CPREV = (bf16_t*)(ws + OFF_CPREV) + (size_t)h * 64 * 8192; float* NPREV = (float*)(ws + OFF_NPREV) + h * 64 * 64; float* MPREV = (float*)(ws + OFF_MPREV) + h * 64;
  float cst = 0.f, nst = 0.f, m = 0.f;
  const bool do_n = (sl == 0 && tid < 64);
  for (int c0 = 0; c0 < 64; c0 += 16) {
    float cl[16], bl[16], cm[16], nl[16];
#pragma unroll
    for (int j = 0; j < 16; ++j) {
      cl[j] = CLOC[(size_t)(c0 + j) * 8192 + e]; bl[j] = BL[c0 + j]; cm[j] = CMX[c0 + j];
      nl[j] = do_n ? NLOC[(c0 + j) * 64 + tid] : 0.f;
    }
#pragma unroll
    for (int j = 0; j < 16; ++j) {
      const int c = c0 + j;
      CPREV[(size_t)c * 8192 + e] = f2bf(cst);
      if (do_n) NPREV[c * 64 + tid] = nst;
      if (sl == 0 && tid == 0) MPREV[c] = m;
      const float ml = bl[j] + cm[j];
      const float mn = fmaxf(bl[j] + m, ml), so = __expf(bl[j] + m - mn), sc = __expf(ml - mn);
      cst = so * cst + sc * cl[j];
      nst = so * nst + sc * nl[j];
      m = mn;
    }
  }
}

__device__ __forceinline__ void mlstm_out(const Params& p, int l, int h, int c, unsigned char* lds) {
  unsigned char* ws = ows(p.ws);
  const float* MIF = (const float*)(ws + OFF_MIF); const bf16_t* MQ = (const bf16_t*)(ws + OFF_MQ); const bf16_t* MK = (const bf16_t*)(ws + OFF_MK);
  const bf16_t* MVT = (const bf16_t*)(ws + OFF_MVT); const bf16_t* MO = (const bf16_t*)(ws + OFF_MO); bf16_t* YB = (bf16_t*)(ws + OFF_YB);
  const bf16_t* CPREV = (const bf16_t*)(ws + OFF_CPREV) + (size_t)(h * 64 + c) * 8192; const float* NPREV = (const float*)(ws + OFF_NPREV) + (h * 64 + c) * 64;
  const float mprev = ((const float*)(ws + OFF_MPREV))[h * 64 + c];
  const float* hn = p.head_norm + l * 1024 + h * 128;
  float* sB = (float*)(lds + 65536); float* sU = sB + 128; float* sCM = sU + 128; float* sN = sCM + 128;
  const int tid = otid(), lane = tid & 63, w = tid >> 6, l15 = lane & 15, lg = lane >> 4, t0 = c * 128;
  mlstm_gates(MIF, t0, h, p.b_i[l * 8 + h], p.b_f[l * 8 + h], sB, sU, sCM);
#pragma unroll
  for (int i = 0; i < 8; ++i) {
    const int cc = tid + i * 256, dv = cc >> 4, ch = cc & 15;
    *(uint4*)(lds + swz16(dv, ch)) = *(const uint4*)(MVT + (size_t)(h * 128 + dv) * TR + t0 + ch * 8);
  }
#pragma unroll
  for (int i = 0; i < 4; ++i) {
    const int cc = tid + i * 256, dv = cc >> 3, ch = cc & 7;
    *(uint4*)(lds + 49152 + swz8(dv, ch)) = *(const uint4*)(CPREV + dv * 64 + ch * 8);
  }
  if (tid < 64) sN[tid] = NPREV[tid];
  __syncthreads();
#pragma unroll
  for (int mt = 0; mt < 2; ++mt) {
    const int tl = w * 32 + mt * 16 + l15;
    const float Mt = fmaxf(mprev, sCM[tl]), inter = __expf(mprev - Mt), bt = sB[tl];
    bf16x8 qf[2];
#pragma unroll
    for (int ks = 0; ks < 2; ++ks) qf[ks] = *(const bf16x8*)(MQ + (size_t)(t0 + tl) * 512 + h * 64 + ks * 32 + lg * 8);
    f32x4 acc[8];
#pragma unroll
    for (int dt = 0; dt < 8; ++dt) acc[dt] = (f32x4){0.f, 0.f, 0.f, 0.f};
#pragma unroll
    for (int ks = 0; ks < 2; ++ks)
#pragma unroll
      for (int dt = 0; dt < 8; ++dt) {
        const bf16x8 cf = *(const bf16x8*)(lds + 49152 + swz8(dt * 16 + l15, ks * 4 + lg));
        acc[dt] = MFMA(cf, qf[ks], acc[dt]);
      }
    float dn = 0.f;
#pragma unroll
    for (int ks = 0; ks < 2; ++ks)
#pragma unroll
      for (int j = 0; j < 8; ++j) dn += bf2f((bf16_t)qf[ks][j]) * sN[ks * 32 + lg * 8 + j];
    dn = red4(dn) * inter;
#pragma unroll
    for (int dt = 0; dt < 8; ++dt) acc[dt] *= inter;
    const int ntmax = 2 * w + mt;
    f32x4 s[8];
    float rsum = 0.f;
#pragma unroll
    for (int nt = 0; nt < 8; ++nt) {
      s[nt] = (f32x4){0.f, 0.f, 0.f, 0.f};
      if (nt <= ntmax) {
#pragma unroll
        for (int ks = 0; ks < 2; ++ks) {
          const bf16x8 kf = *(const bf16x8*)(MK + (size_t)(t0 + nt * 16 + l15) * 512 + h * 64 + ks * 32 + lg * 8);
          s[nt] = MFMA(kf, qf[ks], s[nt]);
        }
#pragma unroll
        for (int jj = 0; jj < 4; ++jj) {
          const int sl = nt * 16 + lg * 4 + jj;
          const float wv = sl <= tl ? __expf(sU[sl] - Mt) : 0.f;
          const float pv = s[nt][jj] * wv;
          s[nt][jj] = pv; rsum += pv;
        }
      }
    }
    const float den = dn + red4(rsum);
#pragma unroll
    for (int kk = 0; kk < 4; ++kk) {
      if (2 * kk <= ntmax) {
        union { bf16x8 v; unsigned u[4]; } pf;
        pf.u[0] = pk2(s[2 * kk][0], s[2 * kk][1]); pf.u[1] = pk2(s[2 * kk][2], s[2 * kk][3]);
        pf.u[2] = pk2(s[2 * kk + 1][0], s[2 * kk + 1][1]); pf.u[3] = pk2(s[2 * kk + 1][2], s[2 * kk + 1][3]);
#pragma unroll
        for (int dt = 0; dt < 8; ++dt) {
          const int row = dt * 16 + l15;
          union { bf16x8 v; uint2 h2[2]; } vf;
          vf.h2[0] = *(const uint2*)(lds + swz16(row, kk * 4 + (lg >> 1)) + (lg & 1) * 8);
          vf.h2[1] = *(const uint2*)(lds + swz16(row, kk * 4 + 2 + (lg >> 1)) + (lg & 1) * 8);
          acc[dt] = MFMA(vf.v, pf.v, acc[dt]);
        }
      }
    }
    const float mt_ = bt + Mt;
    const float inv = 1.f / fmaxf(fabsf(den), __expf(-mt_));
    float ssq = 0.f;
#pragma unroll
    for (int dt = 0; dt < 8; ++dt) { acc[dt] *= inv; ssq += acc[dt][0] * acc[dt][0] + acc[dt][1] * acc[dt][1] + acc[dt][2] * acc[dt][2] + acc[dt][3] * acc[dt][3]; }
    ssq = red4(ssq);
    const float rn = rsqrtf(ssq * (1.f / 128.f) + EPS);
#pragma unroll
    for (int dt = 0; dt < 8; ++dt) {
      const int dv = dt * 16 + lg * 4;
      const float4 g = *(const float4*)(hn + dv);
      const uint2 og = *(const uint2*)(MO + (size_t)(t0 + tl) * 1024 + h * 128 + dv);
      st4bf(YB + (size_t)(t0 + tl) * 1024 + h * 128 + dv, acc[dt][0] * rn * g.x * sigmoidf_(bflo(og.x)), acc[dt][1] * rn * g.y * sigmoidf_(bfhi(og.x)),
            acc[dt][2] * rn * g.z * sigmoidf_(bflo(og.y)), acc[dt][3] * rn * g.w * sigmoidf_(bfhi(og.y)));
    }
  }
  __syncthreads();
}

__device__ __forceinline__ void conv_item(const Params& p, int l, int item) {
  unsigned char* ws = ows(p.ws);
  const bf16_t* CONV = (const bf16_t*)(ws + OFF_CONV); bf16_t* YA = (bf16_t*)(ws + OFF_YA);
  const float* cw = p.conv_w + l * 3 * 1024;
  const int tid = otid();
#pragma unroll 2
  for (int i = 0; i < 8; ++i) {
    const int cc = tid + i * 256, t = item * 16 + (cc >> 7), c = (cc & 127) * 8;
    const uint4 gb = *(const uint4*)(CONV + (size_t)t * 3072 + c);
    float z[3][8];
#pragma unroll
    for (int d = 0; d < 3; ++d) {
      const int tt = t - 2 + d;
      if (tt >= 0) {
        const uint4 a = *(const uint4*)(CONV + (size_t)tt * 3072 + 1024 + c), u = *(const uint4*)(CONV + (size_t)tt * 3072 + 2048 + c);
        z[d][0] = bflo(a.x) * bflo(u.x); z[d][1] = bfhi(a.x) * bfhi(u.x); z[d][2] = bflo(a.y) * bflo(u.y); z[d][3] = bfhi(a.y) * bfhi(u.y);
        z[d][4] = bflo(a.z) * bflo(u.z); z[d][5] = bfhi(a.z) * bfhi(u.z); z[d][6] = bflo(a.w) * bflo(u.w); z[d][7] = bfhi(a.w) * bfhi(u.w);
      } else {
#pragma unroll
        for (int j = 0; j < 8; ++j) z[d][j] = 0.f;
      }
    }
    float y[8];
#pragma unroll
    for (int j = 0; j < 8; ++j) y[j] = cw[c + j] * z[0][j] + cw[1024 + c + j] * z[1][j] + cw[2048 + c + j] * z[2][j];
    uint4 o;
    o.x = pk2(bflo(gb.x) * y[0], bfhi(gb.x) * y[1]); o.y = pk2(bflo(gb.y) * y[2], bfhi(gb.y) * y[3]);
    o.z = pk2(bflo(gb.z) * y[4], bfhi(gb.z) * y[5]); o.w = pk2(bflo(gb.w) * y[6], bfhi(gb.w) * y[7]);
    *(uint4*)(YA + (size_t)t * 1024 + c) = o;
  }
}

constexpr float QSCALE = 0.07216878364870322f * 1.4426950408889634f;

__device__ __forceinline__ void uq_tile(const Params& p, int l, int b, int tile, unsigned char* lds) {
  unsigned char* ws = ows(p.ws);
  const bf16_t* CQ = (const bf16_t*)(ws + OFF_CQ); const bf16_t* WT = (const bf16_t*)(ws + OFF_WUQ + l * SZ_WUQ);
  const float* SSCQ = (const float*)(ws + OFF_SSCQ); bf16_t* Q = (bf16_t*)(ws + OFF_Q);
  const float* COS = (const float*)(ws + OFF_COS) + (size_t)b * TR * 32; const float* SIN = (const float*)(ws + OFF_SIN) + (size_t)b * TR * 32;
  const float* qn = p.q_norm + l * 192;
  const int mtile = tile & 63, ntile = tile >> 6;
  const int tix = otid(), lane = tix & 63, wid = tix >> 6, l15 = lane & 15, lg = lane >> 4;
  f32x4 acc[2][8];
  gemm_core<4, 1>(CQ + (size_t)mtile * 128 * 256, 256, WT + (size_t)ntile * 128 * 256, 256, 256, lds, acc);
#pragma unroll
  for (int mt = 0; mt < 2; ++mt) {
    const int row = mtile * 128 + wid * 32 + mt * 16 + l15;
    const float4 sq = *(const float4*)(SSCQ + (size_t)row * 4);
    const float ra = rsqrtf((sq.x + sq.y + sq.z + sq.w) * (1.f / 256.f) + EPS);
#pragma unroll
    for (int nt = 0; nt < 8; ++nt) acc[mt][nt] *= ra;
    if (ntile < 8) {
      float s = 0.f;
#pragma unroll
      for (int nt = 0; nt < 8; ++nt) { const f32x4 v = acc[mt][nt]; s += v[0] * v[0] + v[1] * v[1] + v[2] * v[2] + v[3] * v[3]; }
      s = red4(s);
      const float rn = rsqrtf(s * (1.f / 128.f) + EPS) * QSCALE;
#pragma unroll
      for (int nt = 0; nt < 8; ++nt) {
        const int c = nt * 16 + lg * 4; const float4 g = *(const float4*)(qn + c); const f32x4 v = acc[mt][nt];
        st4bf(Q + ((size_t)row * 8 + ntile) * 192 + c, v[0] * rn * g.x, v[1] * rn * g.y, v[2] * rn * g.z, v[3] * rn * g.w);
      }
    } else {
#pragma unroll
      for (int hf = 0; hf < 2; ++hf) {
        const int h = (ntile - 8) * 2 + hf;
        float s = 0.f;
#pragma unroll
        for (int nt = 0; nt < 4; ++nt) { const f32x4 v = acc[mt][hf * 4 + nt]; s += v[0] * v[0] + v[1] * v[1] + v[2] * v[2] + v[3] * v[3]; }
        s = red4(s);
        const float rn = rsqrtf(s * (1.f / 64.f) + EPS);
#pragma unroll
        for (int nt = 0; nt < 2; ++nt) {
          const int c = nt * 16 + lg * 4;
          const float4 cs = *(const float4*)(COS + (size_t)row * 32 + c), sn = *(const float4*)(SIN + (size_t)row * 32 + c);
          const float4 g1 = *(const float4*)(qn + 128 + c), g2 = *(const float4*)(qn + 160 + c);
          const f32x4 a = acc[mt][hf * 4 + nt], b2 = acc[mt][hf * 4 + nt + 2];
          const float x10 = a[0] * rn * g1.x, x11 = a[1] * rn * g1.y, x12 = a[2] * rn * g1.z, x13 = a[3] * rn * g1.w;
          const float x20 = b2[0] * rn * g2.x, x21 = b2[1] * rn * g2.y, x22 = b2[2] * rn * g2.z, x23 = b2[3] * rn * g2.w;
          st4bf(Q + ((size_t)row * 8 + h) * 192 + 128 + c, (x10 * cs.x - x20 * sn.x) * QSCALE, (x11 * cs.y - x21 * sn.y) * QSCALE,
                (x12 * cs.z - x22 * sn.z) * QSCALE, (x13 * cs.w - x23 * sn.w) * QSCALE);
          st4bf(Q + ((size_t)row * 8 + h) * 192 + 160 + c, (x10 * sn.x + x20 * cs.x) * QSCALE, (x11 * sn.y + x21 * cs.y) * QSCALE,
                (x12 * sn.z + x22 * cs.z) * QSCALE, (x13 * sn.w + x23 * cs.w) * QSCALE);
        }
      }
    }
  }
}

__device__ __forceinline__ void ukv_tile(const Params& p, int l, int tile, unsigned char* lds) {
  unsigned char* ws = ows(p.ws);
  const bf16_t* CKV = (const bf16_t*)(ws + OFF_CKV); const bf16_t* WT = (const bf16_t*)(ws + OFF_WUKV + l * SZ_WUKV);
  const float* SSCKV = (const float*)(ws + OFF_SSCKV); bf16_t* KB = (bf16_t*)(ws + OFF_K); bf16_t* VT = (bf16_t*)(ws + OFF_VT);
  const float* kn = p.k_norm + l * 192;
  const int mtile = tile & 63, ntile = tile >> 6;
  const int tix = otid(), lane = tix & 63, wid = tix >> 6, l15 = lane & 15, lg = lane >> 4;
  f32x4 acc[2][8];
  gemm_core<4, 1>(CKV + (size_t)mtile * 128 * 128, 128, WT + (size_t)ntile * 128 * 128, 128, 128, lds, acc);
#pragma unroll
  for (int mt = 0; mt < 2; ++mt) {
    const int row = mtile * 128 + wid * 32 + mt * 16 + l15;
    const float ra = rsqrtf((SSCKV[row * 2] + SSCKV[row * 2 + 1]) * (1.f / 128.f) + EPS);
#pragma unroll
    for (int nt = 0; nt < 8; ++nt) acc[mt][nt] *= ra;
    if (ntile < 8) {
      float s = 0.f;
#pragma unroll
      for (int nt = 0; nt < 8; ++nt) { const f32x4 v = acc[mt][nt]; s += v[0] * v[0] + v[1] * v[1] + v[2] * v[2] + v[3] * v[3]; }
      s = red4(s);
      const float rn = rsqrtf(s * (1.f / 128.f) + EPS);
#pragma unroll
      for (int nt = 0; nt < 8; ++nt) {
        const int c = nt * 16 + lg * 4; const float4 g = *(const float4*)(kn + c); const f32x4 v = acc[mt][nt];
        st4bf(KB + ((size_t)row * 8 + ntile) * 192 + c, v[0] * rn * g.x, v[1] * rn * g.y, v[2] * rn * g.z, v[3] * rn * g.w);
      }
    } else {
      const int h = ntile - 8;
#pragma unroll
      for (int nt = 0; nt < 8; ++nt)
#pragma unroll
        for (int jj = 0; jj < 4; ++jj) VT[(size_t)(h * 128 + nt * 16 + lg * 4 + jj) * TR + row] = f2bf(acc[mt][nt][jj]);
    }
  }
}

__device__ __forceinline__ void attn_item(const Params& p, int h, int qb, unsigned char* lds0) {
  unsigned char* ws = ows(p.ws); const int half = ohalf(); unsigned char* lds = lds0 + half * LDS_BYTES;
  const bf16_t* Q = (const bf16_t*)(ws + OFF_Q); const bf16_t* KB = (const bf16_t*)(ws + OFF_K); const bf16_t* VT = (const bf16_t*)(ws + OFF_VT);
  bf16_t* YC = (bf16_t*)(ws + OFF_YC);
  const int tid = otid(), lane = tid & 63, w = __builtin_amdgcn_readfirstlane(tid >> 6), l15 = lane & 15, lg = lane >> 4;
  const int r0 = qb * 128 + 32 * w;
  const int fx = (l15 >> 1) & 7, fxc = (fx & 4) << 4;
  const int kfb = l15 * 384 + ((lg ^ (fx & 3)) << 4);
  const int kfe = kfb + fxc, kfo = kfb - fxc;
  const int vfb_ = 24576 + l15 * 128 + (lg & 1) * 8, vg = lg >> 1;
  const int vfa0 = vfb_ + (((0 | vg) ^ (fx & 3)) << 4) + (0 ^ fxc), vfa1 = vfb_ + (((0 | vg) ^ (fx & 3)) << 4) + (64 ^ fxc);
  const int vfb0 = vfb_ + (((2 | vg) ^ (fx & 3)) << 4) + (0 ^ fxc), vfb1 = vfb_ + (((2 | vg) ^ (fx & 3)) << 4) + (64 ^ fxc);
  bf16x8 qf[2][6];
#pragma unroll
  for (int mt = 0; mt < 2; ++mt)
#pragma unroll
    for (int ks = 0; ks < 6; ++ks) qf[mt][ks] = *(const bf16x8*)(Q + ((size_t)(r0 + mt * 16 + l15) * 8 + h) * 192 + ks * 32 + lg * 8);
  f32x4 o[2][8];
#pragma unroll
  for (int mt = 0; mt < 2; ++mt)
#pragma unroll
    for (int dt = 0; dt < 8; ++dt) o[mt][dt] = (f32x4){0.f, 0.f, 0.f, 0.f};
  float mrun[2] = {-INFINITY, -INFINITY}, lsum[2] = {0.f, 0.f};
  const int nh = qb + 1, kt0 = half, nkt = 2 * nh;
  const int skey = tid >> 2, sq = tid & 3, sx = (skey >> 1) & 7;
  const bf16_t* kp = KB + ((size_t)skey * 8 + h) * 192 + sq * 8;
  const int klb = skey * 384 + ((sq ^ (sx & 3)) << 4), kxc = (sx >> 2) << 6;
  const int vdv = tid >> 3, vch = tid & 7;
  const bf16_t* vp = VT + (size_t)(h * 128 + vdv) * TR + vch * 8;
  const int vlo0 = 24576 + swz8(vdv, vch);
  const bf16_t* kq = kp + (size_t)kt0 * 64 * 1536; const bf16_t* vq = vp + kt0 * 64;
  uint4 sk0 = *(const uint4*)kq, sk1 = *(const uint4*)(kq + 32), sk2 = *(const uint4*)(kq + 64), sk3 = *(const uint4*)(kq + 96), sk4 = *(const uint4*)(kq + 128), sk5 = *(const uint4*)(kq + 160);
  uint4 sv0 = *(const uint4*)vq, sv1 = *(const uint4*)(vq + (size_t)32 * TR), sv2 = *(const uint4*)(vq + (size_t)64 * TR), sv3 = *(const uint4*)(vq + (size_t)96 * TR);
  for (int kt = kt0; kt < nkt; kt += 2) {
    __syncthreads();
    *(uint4*)(lds + klb + (0 ^ kxc)) = sk0; *(uint4*)(lds + klb + (64 ^ kxc)) = sk1; *(uint4*)(lds + klb + (128 ^ kxc)) = sk2;
    *(uint4*)(lds + klb + (192 ^ kxc)) = sk3; *(uint4*)(lds + klb + (256 ^ kxc)) = sk4; *(uint4*)(lds + klb + (320 ^ kxc)) = sk5;
    *(uint4*)(lds + vlo0) = sv0; *(uint4*)(lds + vlo0 + 4096) = sv1; *(uint4*)(lds + vlo0 + 8192) = sv2; *(uint4*)(lds + vlo0 + 12288) = sv3;
    __syncthreads();
    {
      const int kn = kt + 2 < nkt ? kt + 2 : kt;
      const bf16_t* k2 = kp + (size_t)kn * 64 * 1536; const bf16_t* v2 = vp + kn * 64;
      sk0 = *(const uint4*)k2; sk1 = *(const uint4*)(k2 + 32); sk2 = *(const uint4*)(k2 + 64); sk3 = *(const uint4*)(k2 + 96); sk4 = *(const uint4*)(k2 + 128); sk5 = *(const uint4*)(k2 + 160);
      sv0 = *(const uint4*)v2; sv1 = *(const uint4*)(v2 + (size_t)32 * TR); sv2 = *(const uint4*)(v2 + (size_t)64 * TR); sv3 = *(const uint4*)(v2 + (size_t)96 * TR);
    }
    if (kt * 64 <= r0 + 31) {
      f32x4 s[2][4];
#pragma unroll
      for (int mt = 0; mt < 2; ++mt) {
        const float ni = mrun[mt] == -INFINITY ? 0.f : -mrun[mt];
#pragma unroll
        for (int nt = 0; nt < 4; ++nt) s[mt][nt] = (f32x4){ni, ni, ni, ni};
      }
#pragma unroll
      for (int ks = 0; ks < 6; ++ks) {
        bf16x8 kf[4];
#pragma unroll
        for (int nt = 0; nt < 4; ++nt) kf[nt] = *(const bf16x8*)(lds + ((ks & 1) ? kfo : kfe) + nt * 6144 + ks * 64);
#pragma unroll
        for (int mt = 0; mt < 2; ++mt)
#pragma unroll
          for (int nt = 0; nt < 4; ++nt) s[mt][nt] = MFMA(kf[nt], qf[mt][ks], s[mt][nt]);
      }
      if (kt * 64 + 63 > r0) {
#pragma unroll
        for (int mt = 0; mt < 2; ++mt)
#pragma unroll
          for (int nt = 0; nt < 4; ++nt)
#pragma unroll
            for (int jj = 0; jj < 4; ++jj)
              if (kt * 64 + nt * 16 + lg * 4 + jj > r0 + mt * 16 + l15) s[mt][nt][jj] = -INFINITY;
      }
      bf16x8 pf[2][2];
#pragma unroll
      for (int mt = 0; mt < 2; ++mt) {
        float mx = -INFINITY;
#pragma unroll
        for (int nt = 0; nt < 4; ++nt) mx = fmaxf(mx, fmaxf(fmaxf(s[mt][nt][0], s[mt][nt][1]), fmaxf(s[mt][nt][2], s[mt][nt][3])));
        mx = fmaxf(mx, __shfl_xor(mx, 16)); mx = fmaxf(mx, __shfl_xor(mx, 32));
        if (__any(mx > 8.f || mrun[mt] == -INFINITY)) {
          const float d = fmaxf(mx, 0.f);
          const float base = mrun[mt] == -INFINITY ? 0.f : mrun[mt];
          const float alpha = mrun[mt] == -INFINITY ? 0.f : __builtin_amdgcn_exp2f(-d);
          mrun[mt] = base + d;
          lsum[mt] *= alpha;
#pragma unroll
          for (int dt = 0; dt < 8; ++dt) o[mt][dt] *= alpha;
#pragma unroll
          for (int nt = 0; nt < 4; ++nt) s[mt][nt] -= d;
        }
        float rsum = 0.f;
#pragma unroll
        for (int nt = 0; nt < 4; ++nt)
#pragma unroll
          for (int jj = 0; jj < 4; ++jj) { const float pv = __builtin_amdgcn_exp2f(s[mt][nt][jj]); s[mt][nt][jj] = pv; rsum += pv; }
        lsum[mt] += rsum;
#pragma unroll
        for (int kk = 0; kk < 2; ++kk) {
          union { bf16x8 v; unsigned u[4]; } t;
          t.u[0] = pk2(s[mt][2 * kk][0], s[mt][2 * kk][1]); t.u[1] = pk2(s[mt][2 * kk][2], s[mt][2 * kk][3]);
          t.u[2] = pk2(s[mt][2 * kk + 1][0], s[mt][2 * kk + 1][1]); t.u[3] = pk2(s[mt][2 * kk + 1][2], s[mt][2 * kk + 1][3]);
          pf[mt][kk] = t.v;
        }
      }
#pragma unroll
      for (int kk = 0; kk < 2; ++kk)
#pragma unroll
        for (int dt = 0; dt < 8; ++dt) {

          union { bf16x8 v; uint2 h2[2]; } vf;
          vf.h2[0] = *(const uint2*)(lds + (kk ? vfa1 : vfa0) + dt * 2048);
          vf.h2[1] = *(const uint2*)(lds + (kk ? vfb1 : vfb0) + dt * 2048);
#pragma unroll
          for (int mt = 0; mt < 2; ++mt) o[mt][dt] = MFMA(vf.v, pf[mt][kk], o[mt][dt]);
        }
    }
  }
  __syncthreads();
  unsigned char* xr = lds0 + LDS_BYTES;
  if (half == 1) {
#pragma unroll
    for (int mt = 0; mt < 2; ++mt)
#pragma unroll
      for (int dt = 0; dt < 8; ++dt) *(f32x4*)(xr + ((mt * 8 + dt) * 256 + tid) * 16) = o[mt][dt];
    *(f32x4*)(xr + 65536 + tid * 16) = (f32x4){mrun[0], mrun[1], lsum[0], lsum[1]};
  }
  __syncthreads();
  if (half == 0) {
    const f32x4 ml = *(const f32x4*)(xr + 65536 + tid * 16);
#pragma unroll
    for (int mt = 0; mt < 2; ++mt) {
      const float m1 = ml[mt], l1 = ml[2 + mt];
      const float mn = fmaxf(mrun[mt], m1);
      const float a0 = __builtin_amdgcn_exp2f(mrun[mt] - mn), a1 = __builtin_amdgcn_exp2f(m1 - mn);
      const float inv = 1.f / red4(lsum[mt] * a0 + l1 * a1);
      const int row = r0 + mt * 16 + l15;
#pragma unroll
      for (int dt = 0; dt < 8; ++dt) {
        const f32x4 o1 = *(const f32x4*)(xr + ((mt * 8 + dt) * 256 + tid) * 16);
        o[mt][dt] = (o[mt][dt] * a0 + o1 * a1) * inv;
      }
#pragma unroll
      for (int dt = 0; dt < 8; dt += 2) st_pair(YC + (size_t)row * 1024 + h * 128 + dt * 16, o[mt][dt], o[mt][dt + 1], lg);
    }
  }
}

__device__ __forceinline__ void phase4(const Params& p, int l, unsigned char* lds) {
  unsigned char* ws = ows(p.ws);
  const bf16_t* Y = (const bf16_t*)(ws + OFF_YA); const bf16_t* WT = (const bf16_t*)(ws + OFF_WBR + l * SZ_WBR);
  const bf16_t* GATES = (const bf16_t*)(ws + OFF_GATES); bf16_t* MRG = (bf16_t*)(ws + OFF_MRG);
  for (int tile = blockIdx.x; tile < 32 * 8; tile += gridDim.x) {
    const int mtile = tile & 31, ntile = tile >> 5;
    f32x4 macc[4][4];
#pragma unroll
    for (int mt = 0; mt < 4; ++mt)
#pragma unroll
      for (int nt = 0; nt < 4; ++nt) macc[mt][nt] = (f32x4){0.f, 0.f, 0.f, 0.f};
#pragma unroll 1
    for (int br = 0; br < 3; ++br) {
      f32x4 acc[4][4];
      gemm256x128(Y + (size_t)br * TR * 1024 + (size_t)mtile * 256 * 1024, 1024, WT + (size_t)br * 1024 * 1024 + (size_t)ntile * 128 * 1024, 1024, 1024, lds, acc);
      const int t2 = otid512(), ln2 = t2 & 63, w2 = t2 >> 6;
      const int row0 = mtile * 256 + (w2 >> 1) * 64 + (ln2 & 15), col0 = ntile * 128 + (w2 & 1) * 64 + (ln2 >> 4) * 4;
      const bf16_t* gp = GATES + (size_t)row0 * 3072 + br * 1024 + col0;
#pragma unroll
      for (int mt = 0; mt < 4; ++mt)
#pragma unroll
        for (int nt = 0; nt < 4; ++nt) {
          const uint2 g = *(const uint2*)(gp + mt * 16 * 3072 + nt * 16);
          macc[mt][nt][0] += bflo(g.x) * acc[mt][nt][0]; macc[mt][nt][1] += bfhi(g.x) * acc[mt][nt][1];
          macc[mt][nt][2] += bflo(g.y) * acc[mt][nt][2]; macc[mt][nt][3] += bfhi(g.y) * acc[mt][nt][3];
        }
    }
    {
      const int t2 = otid512(), ln2 = t2 & 63, w2 = t2 >> 6, lg2 = ln2 >> 4;
      bf16_t* op = MRG + (size_t)(mtile * 256 + (w2 >> 1) * 64 + (ln2 & 15)) * 1024 + ntile * 128 + (w2 & 1) * 64;
#pragma unroll
      for (int mt = 0; mt < 4; ++mt) { st_pair(op + mt * 16 * 1024, macc[mt][0], macc[mt][1], lg2); st_pair(op + mt * 16 * 1024 + 32, macc[mt][2], macc[mt][3], lg2); }
    }
  }
}

__device__ __forceinline__ void gemm_resid(const bf16_t* A, int K, const bf16_t* WT, const float* resid, float* R, bf16_t* XBo, float* SSo, unsigned char* lds) {
  for (int tile = blockIdx.x; tile < 32 * 8; tile += gridDim.x) {
    const int mtile = tile & 31, ntile = tile >> 5;
    f32x4 acc[4][4];
    gemm256x128(A + (size_t)mtile * 256 * K, K, WT + (size_t)ntile * 128 * K, K, K, lds, acc);
    const int tix = otid512(), lane = tix & 63, wid = tix >> 6, wr = wid >> 1, wc = wid & 1, l15 = lane & 15, lg = lane >> 4;
    const int rbase = mtile * 256 + wr * 64, cbase = ntile * 128 + wc * 64;
#pragma unroll
    for (int mt = 0; mt < 4; ++mt) {
      const int row = rbase + mt * 16 + l15;
      float s = 0.f;
#pragma unroll
      for (int nt = 0; nt < 4; ++nt) {
        const size_t off = (size_t)row * 1024 + cbase + nt * 16 + lg * 4;
        const f32x4 v = *(const f32x4*)(resid + off) + acc[mt][nt];
        *(f32x4*)(R + off) = v;
        acc[mt][nt] = v;
        if (XBo) s += v[0] * v[0] + v[1] * v[1] + v[2] * v[2] + v[3] * v[3];
      }
      if (XBo) { bf16_t* rp = XBo + (size_t)row * 1024 + cbase; st_pair(rp, acc[mt][0], acc[mt][1], lg); st_pair(rp + 32, acc[mt][2], acc[mt][3], lg); }
      if (XBo) { s = red4(s); if (lg == 0) SSo[(size_t)row * 16 + ntile * 2 + wc] = s; }
    }
  }
}

__device__ __forceinline__ void phase7(const Params& p, int l, unsigned char* lds) {
  unsigned char* ws = ows(p.ws);
  const bf16_t* XB1 = (const bf16_t*)(ws + OFF_XB1); const bf16_t* WT = (const bf16_t*)(ws + OFF_WUP + l * SZ_WUP);
  const float* SS1 = (const float*)(ws + OFF_SS1); bf16_t* H = (bf16_t*)(ws + OFF_H);
  STG_DECL;
  { const int t0 = blockIdx.x < 32 * 16 ? blockIdx.x : 0; g256_issue(STG_ARGS, XB1 + (size_t)(t0 & 31) * 256 * 1024, 1024, WT + (size_t)(t0 >> 5) * 256 * 1024, 1024); }
  for (int tile = blockIdx.x; tile < 32 * 16; tile += gridDim.x) {
    const int mtile = tile & 31, ntile = tile >> 5;
    f32x4 acc[8][4];
    gemm256(XB1 + (size_t)mtile * 256 * 1024, 1024, WT + (size_t)ntile * 256 * 1024, 1024, 1024, lds, acc, STG_ARGS);
    { const int nx = tile + (int)gridDim.x < 32 * 16 ? tile + (int)gridDim.x : tile;
      g256_issue(STG_ARGS, XB1 + (size_t)(nx & 31) * 256 * 1024, 1024, WT + (size_t)(nx >> 5) * 256 * 1024, 1024); }
    const int tix = otid512(), lane = tix & 63, wid = tix >> 6, l15 = lane & 15, lg = lane >> 4;
    const int rbase = mtile * 256 + (wid >> 2) * 128, cbase = ntile * 256 + (wid & 3) * 64;
#pragma unroll
    for (int mt = 0; mt < 8; ++mt) {
      const int row = rbase + mt * 16 + l15;
      const float4* sp = (const float4*)(SS1 + (size_t)row * 16);
      const float4 a = sp[0], b2 = sp[1], c = sp[2], d = sp[3];
      const float s = (a.x + a.y + a.z + a.w) + (b2.x + b2.y + b2.z + b2.w) + (c.x + c.y + c.z + c.w) + (d.x + d.y + d.z + d.w);
      const float r = rsqrtf(s * (1.f / 1024.f) + EPS);
#pragma unroll
      for (int nt = 0; nt < 4; ++nt) {
        f32x4 v = acc[mt][nt] * r;
#pragma unroll
        for (int jj = 0; jj < 4; ++jj) { const float t = fmaxf(v[jj], 0.f); v[jj] = t * t; }
        acc[mt][nt] = v;
      }
      { bf16_t* rp = H + (size_t)row * 4096 + cbase;
        st_pair(rp, acc[mt][0], acc[mt][1], lg); st_pair(rp + 32, acc[mt][2], acc[mt][3], lg); }
    }
  }
}

#define XB_TMO      128
#define XB_XCNT(j)  (256  + 64 * (j))
#define XB_XSUB(j)  (1280 + 64 * (j))
#define XB_XGEN(j)  (2304 + 64 * (j))
#define XB_TOP      3328
#define XB_TOPGEN   3392
#define XCD_BAR_WORDS 3456
#define XB_SPIN_CAP (1u << 18)
#define LAS __attribute__((address_space(3)))

__device__ __forceinline__ unsigned xb_ld(unsigned* p)              { return __hip_atomic_load(p, __ATOMIC_RELAXED, __HIP_MEMORY_SCOPE_AGENT); }
__device__ __forceinline__ unsigned xb_add(unsigned* p, unsigned v) { return __hip_atomic_fetch_add(p, v, __ATOMIC_RELAXED, __HIP_MEMORY_SCOPE_AGENT); }
__device__ __forceinline__ unsigned xb_xcc_id() { return (unsigned)__builtin_amdgcn_s_getreg((3 << 11) | 20) & 0xFu; }
#define XB_SPIN(cond, bar) do { unsigned _sp = 0; while (cond) { __builtin_amdgcn_s_sleep(1); \
    if ((++_sp & 255u) == 0u) { if (xb_ld(&(bar)[XB_TMO])) break; if (_sp > XB_SPIN_CAP) { atomicAdd(&(bar)[XB_TMO], 1u); break; } } } } while (0)

struct XcdBarrier {
    unsigned* bar; unsigned x;
    volatile LAS unsigned* st;
};

__device__ __forceinline__ XcdBarrier xcd_barrier_post(unsigned* bar, volatile LAS unsigned* st) {
    XcdBarrier b; b.bar = bar; b.x = xb_xcc_id(); b.st = st;
    if (threadIdx.x == 0) (void)xb_add(&bar[XB_XCNT(b.x)], 1u);
    return b;
}
__device__ __forceinline__ void xcd_barrier_complete(unsigned* bar, unsigned x, unsigned& nloc, unsigned& nx) {
    const unsigned G = gridDim.x * gridDim.y * gridDim.z;
    unsigned sum, cnt, mine, sp = 0u;
    for (;;) {
        sum = 0u; cnt = 0u; mine = 0u;
#pragma unroll
        for (unsigned j = 0; j < 16; ++j) { const unsigned c = xb_ld(&bar[XB_XCNT(j)]); sum += c; cnt += (c > 0u) ? 1u : 0u; mine = (j == x) ? c : mine; }
        if (sum == G) break;
        __builtin_amdgcn_s_sleep(1);
        if ((++sp & 255u) == 0u) { if (xb_ld(&bar[XB_TMO])) break; if (sp > XB_SPIN_CAP) { atomicAdd(&bar[XB_TMO], 1u); break; } }
    }
    nloc = mine > 0u ? mine : 1u; nx = cnt > 0u ? cnt : 1u;
}

__device__ __forceinline__ void xcd_barrier(const XcdBarrier& b) {
    asm volatile("s_waitcnt vmcnt(0)" ::: "memory");
    __syncthreads();
    if (threadIdx.x == 0) {
        unsigned* bar = b.bar; const unsigned bx = xb_xcc_id();
        __builtin_amdgcn_s_waitcnt(0);
        unsigned nloc = b.st[0], nx = b.st[1];
        if (nloc == 0u) { xcd_barrier_complete(bar, bx, nloc, nx); b.st[0] = nloc; b.st[1] = nx; }
        const unsigned old = xb_add(&bar[XB_XSUB(bx)], 1u);
        const unsigned gen = old / nloc;
        if (old + 1u == (gen + 1u) * nloc) {
            __builtin_amdgcn_fence(__ATOMIC_RELEASE, "agent");
            asm volatile("s_waitcnt vmcnt(0)" ::: "memory");
            const unsigned og = xb_add(&bar[XB_TOP], 1u);
            const unsigned tg = og / nx;
            if (og + 1u == (tg + 1u) * nx) xb_add(&bar[XB_TOPGEN], 1u);
            else XB_SPIN(xb_ld(&bar[XB_TOPGEN]) == tg, bar);
            __builtin_amdgcn_fence(__ATOMIC_ACQUIRE, "agent");
            xb_add(&bar[XB_XGEN(bx)], 1u);
            asm volatile("s_waitcnt vmcnt(0)" ::: "memory");
        } else {
            XB_SPIN(xb_ld(&bar[XB_XGEN(bx)]) == gen, bar);
            __builtin_amdgcn_fence(__ATOMIC_ACQUIRE, "agent");
            asm volatile("s_waitcnt vmcnt(0)" ::: "memory");
        }
    }
    __syncthreads();
}


__global__ void __launch_bounds__(512, 2) mega(Params p) {
  cg::grid_group grid = cg::this_grid();
  extern __shared__ __attribute__((aligned(16))) unsigned char lds[];
  unsigned char* ws = ows(p.ws);
  const int half = ohalf();
  const int G = gridDim.x, bid = blockIdx.x, G2 = 2 * G, bid2 = 2 * bid + half;
  unsigned char* ldsh = lds + half * LDS_BYTES;
  volatile LAS unsigned* xst = (volatile LAS unsigned*)(lds + 2 * LDS_BYTES);
  if (threadIdx.x == 0) { xst[0] = 0u; xst[1] = 0u; }
  __syncthreads();
  XcdBarrier xb = xcd_barrier_post((unsigned*)(ws + OFF_BAR), xst);
  prologue(p, lds);
  if (p.ws == nullptr) grid.sync();
  xcd_barrier(xb);
  for (int l = 0; l < NLAYER; ++l)
    for (int b = 0; b < NBATCH; ++b) {
      phase1(p, l, b, lds);
      xcd_barrier(xb);
      for (int it = bid2; it < 768 + 1024 + 512 + 512; it += G2) {
        if (it < 768) uq_tile(p, l, b, it, ldsh);
        else if (it < 1792) ukv_tile(p, l, it - 768, ldsh);
        else if (it < 2304) mlstm_local(p, l, (it - 1792) >> 6, (it - 1792) & 63, ldsh);
        else conv_item(p, l, it - 2304);
      }
      xcd_barrier(xb);
      for (int it = G2 - 1 - bid2; it < 256; it += G2) mlstm_scan(p, it);
      for (int it = bid; it < 512; it += G) {
        const int h = it & 7, qb = it < 256 ? 63 - (it >> 3) : (it - 256) >> 3;
        attn_item(p, h, qb, lds);
      }
      xcd_barrier(xb);
      for (int it = bid2; it < 512; it += G2) mlstm_out(p, l, it >> 6, it & 63, ldsh);
      xcd_barrier(xb);
      phase4(p, l, lds);
      xcd_barrier(xb);
      {
        const float* resid = l == 0 ? p.x + (size_t)b * TR * 1024 : p.out + (size_t)b * TR * 1024;
        gemm_resid((const bf16_t*)(ws + OFF_MRG), 1024, (const bf16_t*)(ws + OFF_WOUT + l * SZ_WOUT), resid, p.out + (size_t)b * TR * 1024,
                   (bf16_t*)(ws + OFF_XB1), (float*)(ws + OFF_SS1), lds);
      }
      xcd_barrier(xb);
      phase7(p, l, lds);
      xcd_barrier(xb);
      gemm_resid((const bf16_t*)(ws + OFF_H), 4096, (const bf16_t*)(ws + OFF_WDN + l * SZ_WDN), p.out + (size_t)b * TR * 1024, p.out + (size_t)b * TR * 1024,
                 l == 0 ? (bf16_t*)(ws + OFF_XB) + (size_t)b * TR * 1024 : nullptr, (float*)(ws + OFF_SSX) + (size_t)b * TR * 16, lds);
      xcd_barrier(xb);
    }
}

extern "C" void kernel_launch(void* const* d_in, const int* in_sizes, int n_in, void* d_out, int out_size, void* d_ws, size_t ws_size, hipStream_t stream) {
  static int grid_blocks = 0;
  if (!grid_blocks) {
    int dev = 0, cus = 0, per_cu = 0;
    (void)hipGetDevice(&dev);
    (void)hipDeviceGetAttribute(&cus, hipDeviceAttributeMultiprocessorCount, dev);
    (void)hipFuncSetAttribute((const void*)mega, hipFuncAttributeMaxDynamicSharedMemorySize, (int)LDS_TOTAL);
    (void)hipOccupancyMaxActiveBlocksPerMultiprocessor(&per_cu, mega, 512, LDS_TOTAL);
    if (per_cu > 1) per_cu = 1;
    grid_blocks = cus * per_cu;
  }
  Params p{};
  p.x = (const float*)d_in[0]; p.pos = (const int*)d_in[1]; p.mix_norm = (const float*)d_in[2]; p.w_in = (const float*)d_in[3];
  p.conv_w = (const float*)d_in[4]; p.b_i = (const float*)d_in[5]; p.b_f = (const float*)d_in[6]; p.head_norm = (const float*)d_in[7];
  p.q_a_norm = (const float*)d_in[8]; p.w_uq = (const float*)d_in[9]; p.kv_a_norm = (const float*)d_in[10]; p.w_ukv = (const float*)d_in[11];
  p.q_norm = (const float*)d_in[12]; p.k_norm = (const float*)d_in[13]; p.w_branch = (const float*)d_in[14]; p.w_out = (const float*)d_in[15];
  p.mlp_norm = (const float*)d_in[16]; p.w_up = (const float*)d_in[17]; p.w_down = (const float*)d_in[18];
  p.out = (float*)d_out; p.ws = (unsigned char*)d_ws;
  (void)hipMemsetAsync((unsigned char*)d_ws + OFF_BAR, 0, XCD_BAR_WORDS * 4, stream);
  void* args[] = {&p};
  hipError_t e = hipLaunchCooperativeKernel((void*)mega, dim3(grid_blocks), dim3(512), args, LDS_TOTAL, stream);
  if (e != hipSuccess) fprintf(stderr, "cooperative launch failed: %s (grid %d)\n", hipGetErrorString(e), grid_blocks);
}
```
